# Optimizing an MI355X kernel written in HIP

```python
import jax, jax.numpy as jnp
from jax import lax
import numpy as np

D_MODEL = 1024
BATCH = 8
SEQ = 2048
DEPTH = 1

CONV_GROUPS = 8
CONV_GROUP_DIM = 64
D_CONV = CONV_GROUPS * CONV_GROUP_DIM
CONV_WIDTH = 3
RWKV_HEADS = 8
RWKV_HEAD = 64
D_RWKV = RWKV_HEADS * RWKV_HEAD
D_MIX = D_CONV + D_RWKV
DECAY_LORA = 64
AAA_LORA = 64
GATE_LORA = 128
D_RWKV_PROJ = 3 * D_RWKV + DECAY_LORA + AAA_LORA + GATE_LORA
D_IN = 3 * D_CONV + D_RWKV_PROJ
N_GROUPS = 4
EXPERTS_PER_GROUP = 8
N_EXPERTS = N_GROUPS * EXPERTS_PER_GROUP
TOP_K_IN_GROUP = 2
D_EXPERT = D_MODEL // 4
RMS_EPS = 1e-6
LN_X_EPS = 64e-5
L2_EPS = 1e-12

kernel_name = "hybrid_conv_rwkv7_hmoe_block"


def rms_norm(x, g):
    xf = x.astype(jnp.float32)
    y = xf * lax.rsqrt(jnp.mean(xf * xf, axis=-1, keepdims=True) + RMS_EPS)
    return y.astype(x.dtype) * g


def token_shift(z):
    return jnp.pad(z, ((0, 0), (1, 0), (0, 0)))[:, :-1]


def causal_depthwise_conv(u, w):
    return lax.conv_general_dilated(
        u, w[:, None, :].astype(u.dtype), window_strides=(1,), padding=[(CONV_WIDTH - 1, 0)],
        dimension_numbers=("NWC", "WIO", "NWC"), feature_group_count=u.shape[-1])


def short_conv_mixer(z, conv_w):
    b_gate, c_gate, h = jnp.split(z, 3, axis=-1)
    return b_gate * causal_depthwise_conv(c_gate * h, conv_w)


def rwkv7_recurrence(r, decay, k, v, kk, a):
    bsz = r.shape[0]
    to_time = lambda t: jnp.moveaxis(t.astype(jnp.float32), 1, 0)

    def step(S, inp):
        r_t, w_t, k_t, v_t, kk_t, a_t = inp
        s_kk = jnp.einsum("bhvk,bhk->bhv", S, -kk_t)
        S = (S * w_t[:, :, None, :]
             + s_kk[..., None] * (kk_t * a_t)[:, :, None, :]
             + v_t[..., None] * k_t[:, :, None, :])
        o_t = jnp.einsum("bhvk,bhk->bhv", S, r_t)
        return S, o_t

    S0 = jnp.zeros((bsz, RWKV_HEADS, RWKV_HEAD, RWKV_HEAD), jnp.float32)
    _, o = lax.scan(step, S0, (to_time(r), to_time(decay), to_time(k),
                               to_time(v), to_time(kk), to_time(a)))
    return jnp.moveaxis(o, 0, 1)


def rwkv7_mixer(z, mu, decay_up, decay_base, aaa_up, aaa_base, gate_up,
                k_k, k_a, r_k, ln_w, ln_b):
    bsz, seq, _ = z.shape
    zs = z + (token_shift(z) - z) * mu
    cuts = [D_RWKV, 2 * D_RWKV, 3 * D_RWKV, 3 * D_RWKV + DECAY_LORA,
            3 * D_RWKV + DECAY_LORA + AAA_LORA]
    r, k, v, w_lo, a_lo, g_lo = jnp.split(zs, cuts, axis=-1)
    w = -jax.nn.softplus(-(decay_base + jnp.tanh(w_lo) @ decay_up)) - 0.5
    decay = jnp.exp(-jnp.exp(w.astype(jnp.float32)))
    a = jax.nn.sigmoid(aaa_base + a_lo @ aaa_up)
    g = jax.nn.sigmoid(g_lo) @ gate_up
    heads = lambda t: t.reshape(bsz, seq, RWKV_HEADS, RWKV_HEAD)
    kk = heads(k * k_k).astype(jnp.float32)
    kk = kk / jnp.maximum(jnp.linalg.norm(kk, axis=-1, keepdims=True), L2_EPS)
    k = k * (1.0 + (a - 1.0) * k_a)
    rh, kh, vh, ah = heads(r), heads(k), heads(v), heads(a)
    o = rwkv7_recurrence(rh, heads(decay), kh, vh, kk, ah)
    mean = jnp.mean(o, axis=-1, keepdims=True)
    var = jnp.mean(jnp.square(o - mean), axis=-1, keepdims=True)
    o = ((o - mean) * lax.rsqrt(var + LN_X_EPS)).astype(z.dtype)
    o = o * ln_w.reshape(RWKV_HEADS, RWKV_HEAD) + ln_b.reshape(RWKV_HEADS, RWKV_HEAD)
    bonus = jnp.sum(rh * kh * r_k, axis=-1, keepdims=True) * vh
    return (o + bonus).reshape(bsz, seq, D_RWKV) * g


def hierarchical_moe(h, group_w, group_b, expert_w, expert_b, w_gate, w_up, w_down):
    shape = h.shape
    t = h.reshape(-1, shape[-1])
    n_tok = t.shape[0]
    group_prob = jax.nn.softmax((t @ group_w + group_b).astype(jnp.float32), axis=-1)
    g_prob, g_idx = lax.top_k(group_prob, 1)
    e_logits = (t @ expert_w + expert_b).astype(jnp.float32)
    e_logits = e_logits.reshape(n_tok, N_GROUPS, EXPERTS_PER_GROUP)
    in_group = e_logits[jnp.arange(n_tok), g_idx[:, 0]]
    top_logit, top_idx = lax.top_k(in_group, TOP_K_IN_GROUP)
    gates = g_prob * jax.nn.softmax(top_logit, axis=-1)
    expert_idx = g_idx * EXPERTS_PER_GROUP + top_idx
    combine = jnp.sum(jax.nn.one_hot(expert_idx, N_EXPERTS, dtype=jnp.float32)
                      * gates[..., None], axis=1).astype(h.dtype)
    out = jnp.zeros_like(t)
    for e in range(N_EXPERTS):
        hid = jax.nn.silu(t @ w_gate[e]) * (t @ w_up[e])
        out = out + combine[:, e:e + 1] * (hid @ w_down[e])
    return out.reshape(shape)


def setup_inputs(seed: int = 0) -> dict:
    key = jax.random.key(seed)
    ks = jax.random.split(key, 26)
    nrm = lambda k, s, sc: jax.random.normal(k, s, jnp.float32) * sc
    L = DEPTH
    return {
        "x": nrm(ks[0], (BATCH, SEQ, D_MODEL), 1.0),
        "norm_mix_g": 1.0 + nrm(ks[1], (L, D_MODEL), 0.02),
        "w_in": nrm(ks[2], (L, D_MODEL, D_IN), D_MODEL ** -0.5),
        "rwkv_mu": jax.random.uniform(ks[3], (L, D_RWKV_PROJ), jnp.float32),
        "conv_w": nrm(ks[4], (L, CONV_WIDTH, D_CONV), CONV_WIDTH ** -0.5),
        "decay_up": nrm(ks[5], (L, DECAY_LORA, D_RWKV), 0.5 * DECAY_LORA ** -0.5),
        "decay_base": jax.random.uniform(ks[6], (L, D_RWKV), jnp.float32, -6.0, 1.0),
        "aaa_up": nrm(ks[7], (L, AAA_LORA, D_RWKV), 0.5 * AAA_LORA ** -0.5),
        "aaa_base": nrm(ks[8], (L, D_RWKV), 0.1),
        "gate_up": nrm(ks[9], (L, GATE_LORA, D_RWKV), GATE_LORA ** -0.5),
        "k_k": 0.85 + nrm(ks[10], (L, D_RWKV), 0.05),
        "k_a": 1.0 + nrm(ks[11], (L, D_RWKV), 0.05),
        "r_k": nrm(ks[12], (L, RWKV_HEADS, RWKV_HEAD), 0.1),
        "ln_x_w": 1.0 + nrm(ks[13], (L, D_RWKV), 0.02),
        "ln_x_b": nrm(ks[14], (L, D_RWKV), 0.02),
        "w_out": nrm(ks[15], (L, D_MIX, D_MODEL), D_MIX ** -0.5),
        "norm_ffn_g": 1.0 + nrm(ks[16], (L, D_MODEL), 0.02),
        "router_group_w": nrm(ks[17], (L, D_MODEL, N_GROUPS), D_MODEL ** -0.5),
        "router_group_b": nrm(ks[18], (L, N_GROUPS), 0.01),
        "router_expert_w": nrm(ks[19], (L, D_MODEL, N_EXPERTS), D_MODEL ** -0.5),
        "router_expert_b": nrm(ks[20], (L, N_EXPERTS), 0.01),
        "expert_w_gate": nrm(ks[21], (L, N_EXPERTS, D_MODEL, D_EXPERT), D_MODEL ** -0.5),
        "expert_w_up": nrm(ks[22], (L, N_EXPERTS, D_MODEL, D_EXPERT), D_MODEL ** -0.5),
        "expert_w_down": nrm(ks[23], (L, N_EXPERTS, D_EXPERT, D_MODEL), D_EXPERT ** -0.5),
        "norm_final_g": 1.0 + nrm(ks[24], (D_MODEL,), 0.02),
    }


def reference(x, norm_mix_g, w_in, rwkv_mu, conv_w, decay_up, decay_base, aaa_up,
              aaa_base, gate_up, k_k, k_a, r_k, ln_x_w, ln_x_b, w_out, norm_ffn_g,
              router_group_w, router_group_b, router_expert_w, router_expert_b,
              expert_w_gate, expert_w_up, expert_w_down, norm_final_g):
    h = x
    for l in range(DEPTH):
        u = rms_norm(h, norm_mix_g[l])
        z = u @ w_in[l]
        y_conv = short_conv_mixer(z[..., :3 * D_CONV], conv_w[l])
        y_rwkv = rwkv7_mixer(z[..., 3 * D_CONV:], rwkv_mu[l], decay_up[l], decay_base[l],
                             aaa_up[l], aaa_base[l], gate_up[l], k_k[l], k_a[l], r_k[l],
                             ln_x_w[l], ln_x_b[l])
        y = jnp.concatenate([y_conv, y_rwkv], axis=-1)
        h = h + y @ w_out[l]
        u = rms_norm(h, norm_ffn_g[l])
        h = h + hierarchical_moe(u, router_group_w[l], router_group_b[l],
                                 router_expert_w[l], router_expert_b[l],
                                 expert_w_gate[l], expert_w_up[l], expert_w_down[l])
    return rms_norm(h, norm_final_g)
```

```cpp
#include <hip/hip_runtime.h>
#include <cstdio>
#include <cstdint>
namespace pg8 {
#define PG8_LAS __attribute__((address_space(3)))
typedef unsigned short bf16_t;
typedef short bf16x8 __attribute__((ext_vector_type(8)));
typedef float f32x4 __attribute__((ext_vector_type(4)));
typedef unsigned u32x4 __attribute__((ext_vector_type(4)));
constexpr int BM = 256, BK = 64, HALF = 128, HTB = HALF * BK * 2  , STAGE_BYTES = 8 * HTB, NXCD = 8, WGM = 8;

__host__ __device__ __forceinline__ int lds_byte(int r, int c) { const int st = (r >> 4) * 2 + (c >> 5), rr = r & 15, cc = c & 31, ob = rr * 64 + cc * 2; return st * 1024 + (ob ^ (((ob >> 9) & 1) << 5)); }
__host__ __device__ __forceinline__ void stage_rc(int b, int& R, int& C) { const int st = b / 1024, sb = b % 1024, swz = sb ^ (((sb >> 9) & 1) << 5); R = (st >> 1) * 16 + swz / 64; C = (st & 1) * 32 + (swz % 64) / 2; }
__host__ __device__ __forceinline__ int perm32(int rho) { const int n = rho >> 4, i = rho & 15; return 8 * (i >> 2) + 4 * n + (i & 3); }


struct Unit { int pm, pn, e; };
struct Gemm { const bf16_t* A; const bf16_t* Bt; int M, N, K; };

struct StaticOrder {
    int nM, nN, nwg, G, c;
    __host__ __device__ void init(int M, int N, int G_, int c_) { nM = M / BM; nN = N / BM; nwg = nM * nN; G = G_; c = c_; }
    __host__ __device__ bool next(int i, Unit& u) const {
        const long L = (long)i * G + c; if (L >= nwg) return false;
        int wgid = (int)L; { const int q = nwg / NXCD, r = nwg % NXCD, xcd = wgid % NXCD, off = wgid / NXCD; wgid = (xcd < r ? xcd * (q + 1) : r * (q + 1) + (xcd - r) * q) + off; }
        const int nig = WGM * nN, gid = wgid / nig, fm = gid * WGM, gsz = (nM - fm) < WGM ? (nM - fm) : WGM;
        u.pm = fm + ((wgid % nig) % gsz); u.pn = (wgid % nig) / gsz; u.e = 0; return true;
    }
    __device__ __forceinline__ const char* a_ptr(const Gemm& g, const Unit& u, size_t tstep) const { return (const char*)g.A + (size_t)u.pm * tstep; }
    __device__ __forceinline__ const char* b_ptr(const Gemm& g, const Unit& u, size_t tstep) const { return (const char*)g.Bt + (size_t)u.pn * tstep; }
    __device__ __forceinline__ void a_ready(const Unit&) const {}
    __device__ __forceinline__ void done(const Unit&) const {}
};
struct MoeOrder {
    const PG8_LAS int* off; int nct, nunits, G, c; size_t estride;
    __device__ __forceinline__ void init(const PG8_LAS int* off_, int nct_, int G_, int c_, size_t estride_) {
        off = off_; nct = nct_; G = G_; c = c_; estride = estride_; nunits = __builtin_amdgcn_readfirstlane((off_[32] >> 8) * nct_); }
    __device__ __forceinline__ bool next(int i, Unit& u) const {
        const int L = i * G + c; if (L >= nunits) return false;
        const int rt = L / nct, ct = L - rt * nct, pos = rt << 8; int e = 0;
#pragma unroll
        for (int j = 1; j < 32; ++j) e += (off[j] <= pos) ? 1 : 0;
        u.pm = rt; u.pn = ct; u.e = __builtin_amdgcn_readfirstlane(e); return true;
    }
    __device__ __forceinline__ const char* a_ptr(const Gemm& g, const Unit& u, size_t tstep) const { return (const char*)g.A + (size_t)u.pm * tstep; }
    __device__ __forceinline__ const char* b_ptr(const Gemm& g, const Unit& u, size_t tstep) const { return (const char*)g.Bt + (size_t)u.e * estride + (size_t)u.pn * tstep; }
    __device__ __forceinline__ void a_ready(const Unit&) const {}
    __device__ __forceinline__ void done(const Unit&) const {}
};

__device__ __forceinline__ unsigned cvt_pk_bf16(float lo, float hi) { unsigned r; asm volatile("v_cvt_pk_bf16_f32 %0, %1, %2" : "=v"(r) : "v"(lo), "v"(hi)); return r; }
template <int ACT  > struct EpiBf16 {
    static constexpr bool PERM = true, AFTER_DRAIN = false; static_assert(ACT == 0, "EpiBf16: ACT is 0 (none)");
    bf16_t* O; int ldc; const float* bias; int split_cols; size_t split_stride; float scale0;
    __device__ __forceinline__ void operator()(const f32x4 (&acc)[2][2][4][2], const Unit& u, int wr, int wc, int fr, int fq) const {
        const int row0 = u.pm * BM + wr * 64 + fr; int colt = u.pn * BM; bf16_t* base = O;
        float sc = 1.f; if (split_cols) { const int t = colt / split_cols; base += (size_t)t * split_stride; colt -= t * split_cols; if (t == 0) sc = scale0; }
        const int col0 = colt + wc * 32 + 8 * fq, bcol0 = u.pn * BM + wc * 32 + 8 * fq;
        f32x4 bv[2][2];
#pragma unroll
        for (int bj = 0; bj < 2; ++bj)
#pragma unroll
            for (int n = 0; n < 2; ++n) bv[bj][n] = bias ? *(const f32x4*)(bias + bcol0 + bj * HALF + 4 * n) : (f32x4){0.f, 0.f, 0.f, 0.f};
#pragma unroll
        for (int ai = 0; ai < 2; ++ai)
#pragma unroll
            for (int m = 0; m < 4; ++m) { bf16_t* rowp = base + (size_t)(row0 + ai * HALF + m * 16) * ldc + col0;
#pragma unroll
                for (int bj = 0; bj < 2; ++bj) { f32x4 v0 = acc[ai][bj][m][0] + bv[bj][0], v1 = acc[ai][bj][m][1] + bv[bj][1];
                    v0 = v0 * sc; v1 = v1 * sc; u32x4 w; w.x = cvt_pk_bf16(v0[0], v0[1]); w.y = cvt_pk_bf16(v0[2], v0[3]); w.z = cvt_pk_bf16(v1[0], v1[1]); w.w = cvt_pk_bf16(v1[2], v1[3]);
                    *(u32x4*)(rowp + bj * HALF) = w; } }
    }
};
struct EpiResF32 {
    static constexpr bool PERM = false, AFTER_DRAIN = false;
    const float* base; float* C; int ldc;
    __device__ __forceinline__ void operator()(const f32x4 (&acc)[2][2][4][2], const Unit& u, int wr, int wc, int fr, int fq) const {
        const int row0 = u.pm * BM + wr * 64 + fr, col0 = u.pn * BM + wc * 32 + 4 * fq;
#pragma unroll
        for (int ai = 0; ai < 2; ++ai)
#pragma unroll
            for (int m = 0; m < 4; ++m) { const size_t o = (size_t)(row0 + ai * HALF + m * 16) * ldc + col0;
#pragma unroll
                for (int bj = 0; bj < 2; ++bj)
#pragma unroll
                    for (int n = 0; n < 2; ++n) *(f32x4*)(C + o + bj * HALF + n * 16) = acc[ai][bj][m][n] + *(const f32x4*)(base + o + bj * HALF + n * 16); }
    }
};
__device__ __forceinline__ float silu_f(float x) { return x * __builtin_amdgcn_rcpf(1.0f + __builtin_amdgcn_exp2f(-1.4426950408889634f * x)); }
struct EpiSwiGLU {
    static constexpr bool PERM = true, AFTER_DRAIN = false;
    bf16_t* H; int ldc;
    __device__ __forceinline__ void operator()(const f32x4 (&acc)[2][2][4][2], const Unit& u, int wr, int wc, int fr, int fq) const {
        const int row0 = u.pm * BM + wr * 64 + fr, col0 = u.pn * HALF + wc * 32 + 8 * fq;
#pragma unroll
        for (int ai = 0; ai < 2; ++ai)
#pragma unroll
            for (int m = 0; m < 4; ++m) { bf16_t* rowp = H + (size_t)(row0 + ai * HALF + m * 16) * ldc + col0;
                const f32x4 g0 = acc[ai][0][m][0], g1 = acc[ai][0][m][1], u0 = acc[ai][1][m][0], u1 = acc[ai][1][m][1];
                u32x4 w; w.x = cvt_pk_bf16(silu_f(g0[0]) * u0[0], silu_f(g0[1]) * u0[1]); w.y = cvt_pk_bf16(silu_f(g0[2]) * u0[2], silu_f(g0[3]) * u0[3]);
                w.z = cvt_pk_bf16(silu_f(g1[0]) * u1[0], silu_f(g1[1]) * u1[1]); w.w = cvt_pk_bf16(silu_f(g1[2]) * u1[2], silu_f(g1[3]) * u1[3]);
                *(u32x4*)rowp = w; }
    }
};

template <class Epi, class Sched, bool ALIGN_EPI = false, bool SP2 = false>
__device__ __forceinline__ void gemm_phase(PG8_LAS unsigned char* lds, const Gemm g, const Sched& S, const Epi& E) {
    const int tid = threadIdx.x, wid = __builtin_amdgcn_readfirstlane(tid >> 6), lane = tid & 63, wr = wid >> 2, wc = wid & 3, fr = lane & 15, fq = lane >> 4;
    const int K = g.K, nt = K / BK;
    unsigned voffA[2], voffB[2];
#pragma unroll
    for (int i = 0; i < 2; ++i) { int R, C; stage_rc(tid * 16 + i * 8192, R, C); const int Rb = Epi::PERM ? ((R & ~31) + perm32(R & 31)) : R;
        voffA[i] = (unsigned)(R * K + C) * 2u; voffB[i] = (unsigned)(Rb * K + C) * 2u; }
    const size_t kstep = (size_t)(BK * 2);
    const size_t hstep = (size_t)HALF * K * 2;
    const size_t tstep = 2 * hstep;
    const unsigned ldsw = (unsigned)wid * 1024u;
    const int aoff = lds_byte(wr * 64 + fr, fq * 8), boff = lds_byte(wc * 32 + fr, fq * 8);
#define PG8_SA(b, h) (((b) * 2 + (h)) * HTB)
#define PG8_SB(b, h) ((4 + (b) * 2 + (h)) * HTB)
#define PG8_STAGE(bufoff, gbase, voff) do { _Pragma("unroll") for (int _i = 0; _i < 2; ++_i) \
        __builtin_amdgcn_global_load_lds((const unsigned*)((const char*)(gbase) + (voff)[_i]), (PG8_LAS unsigned*)(lds + (bufoff) + ldsw + _i * 8192), 16, 0, 0); } while (0)
#define PG8_LDA(dst, b, h) do { _Pragma("unroll") for (int m = 0; m < 4; ++m) _Pragma("unroll") for (int k = 0; k < 2; ++k) dst[m][k] = *(const PG8_LAS bf16x8*)(lds + PG8_SA(b, h) + aoff + m * 2048 + k * 1024); } while (0)
#define PG8_LDB(dst, b, h) do { _Pragma("unroll") for (int n = 0; n < 2; ++n) _Pragma("unroll") for (int k = 0; k < 2; ++k) dst[n][k] = *(const PG8_LAS bf16x8*)(lds + PG8_SB(b, h) + boff + n * 2048 + k * 1024); } while (0)
#define PG8_MMA(ai, bj, At, Bt) do { __builtin_amdgcn_s_setprio(1); _Pragma("unroll") for (int m = 0; m < 4; ++m) _Pragma("unroll") for (int n = 0; n < 2; ++n) _Pragma("unroll") for (int k = 0; k < 2; ++k) \
        acc[ai][bj][m][n] = __builtin_amdgcn_mfma_f32_16x16x32_bf16(Bt[n][k], At[m][k], acc[ai][bj][m][n], 0, 0, 0); __builtin_amdgcn_s_setprio(0); } while (0)
#define PG8_WAIT_V(n) asm volatile("s_waitcnt vmcnt(" #n ")" ::: "memory")
#define PG8_WAIT_L(n) asm volatile("s_waitcnt lgkmcnt(" #n ")" ::: "memory")
#define PG8_BAR __builtin_amdgcn_s_barrier()
#define PG8_SCHED __builtin_amdgcn_sched_barrier(0)
    Unit cur, nxt; int ui = 0;
    if (!S.next(0, cur)) return;
    f32x4 acc[2][2][4][2];
#pragma unroll
    for (int a = 0; a < 2; ++a)
#pragma unroll
        for (int b = 0; b < 2; ++b)
#pragma unroll
            for (int m = 0; m < 4; ++m)
#pragma unroll
                for (int n = 0; n < 2; ++n) acc[a][b][m][n] = (f32x4){0.f, 0.f, 0.f, 0.f};
    bf16x8 At[4][2], B0[2][2], B1[2][2];
    const char* cA = S.a_ptr(g, cur, tstep); const char* cB = S.b_ptr(g, cur, tstep);
    S.a_ready(cur);
    if constexpr (SP2) {
        PG8_STAGE(PG8_SB(0, 0), cB, voffB); PG8_STAGE(PG8_SB(0, 1), cB + hstep, voffB); PG8_STAGE(PG8_SA(0, 0), cA, voffA); PG8_STAGE(PG8_SA(0, 1), cA + hstep, voffA);
        if (wr == 1) PG8_BAR;
        PG8_WAIT_V(2); PG8_BAR;
        PG8_STAGE(PG8_SB(1, 0), cB + kstep, voffB); PG8_STAGE(PG8_SA(1, 0), cA + kstep, voffA); PG8_STAGE(PG8_SB(1, 1), cB + hstep + kstep, voffB);
        PG8_WAIT_V(6); PG8_BAR;
    } else {
        PG8_STAGE(PG8_SB(0, 0), cB, voffB); PG8_STAGE(PG8_SA(0, 0), cA, voffA); PG8_STAGE(PG8_SB(0, 1), cB + hstep, voffB); PG8_STAGE(PG8_SA(0, 1), cA + hstep, voffA);
        if (wr == 1) PG8_BAR;
        PG8_WAIT_V(4); PG8_BAR;
        PG8_STAGE(PG8_SB(1, 0), cB + kstep, voffB); PG8_STAGE(PG8_SA(1, 0), cA + kstep, voffA); PG8_STAGE(PG8_SB(1, 1), cB + hstep + kstep, voffB);
        PG8_WAIT_V(6); PG8_BAR;
    }
    for (;;) {
        const bool has_next = S.next(ui + 1, nxt);
        const char* nA = has_next ? S.a_ptr(g, nxt, tstep) : cA; const char* nB = has_next ? S.b_ptr(g, nxt, tstep) : cB;
        for (int t = 0; t < nt; t += 2) {
            const bool last = (t == nt - 2);
            const char* a1 = cA + (size_t)(t + 1) * kstep;
            const char* a2 = last ? nA : cA + (size_t)(t + 2) * kstep; const char* b2 = last ? nB : cB + (size_t)(t + 2) * kstep;
            const char* a3 = a2 + kstep; const char* b3 = b2 + kstep;
            if (last && has_next) S.a_ready(nxt);
            if constexpr (SP2) {
            PG8_LDB(B0, 0, 0); PG8_LDB(B1, 0, 1); PG8_SCHED; PG8_LDA(At, 0, 0); PG8_STAGE(PG8_SA(1, 1), a1 + hstep, voffA);
            PG8_WAIT_V(8); PG8_WAIT_L(0); PG8_BAR; PG8_MMA(0, 0, At, B0); PG8_MMA(0, 1, At, B1); PG8_BAR; PG8_SCHED;
            PG8_LDA(At, 0, 1); PG8_STAGE(PG8_SB(0, 0), b2, voffB); PG8_STAGE(PG8_SB(0, 1), b2 + hstep, voffB); PG8_STAGE(PG8_SA(0, 0), a2, voffA);
            PG8_WAIT_V(8); PG8_WAIT_L(0); PG8_BAR; PG8_MMA(1, 0, At, B0); PG8_MMA(1, 1, At, B1); PG8_BAR; PG8_SCHED;
            PG8_LDB(B0, 1, 0); PG8_LDB(B1, 1, 1); PG8_SCHED; PG8_LDA(At, 1, 0); PG8_STAGE(PG8_SA(0, 1), a2 + hstep, voffA);
            PG8_WAIT_V(8); PG8_WAIT_L(0); PG8_BAR; PG8_MMA(0, 0, At, B0); PG8_MMA(0, 1, At, B1); PG8_BAR; PG8_SCHED;
            PG8_LDA(At, 1, 1); PG8_STAGE(PG8_SB(1, 0), b3, voffB); PG8_STAGE(PG8_SB(1, 1), b3 + hstep, voffB); PG8_STAGE(PG8_SA(1, 0), a3, voffA);
            PG8_WAIT_V(8); PG8_WAIT_L(0); PG8_BAR; PG8_MMA(1, 0, At, B0); PG8_MMA(1, 1, At, B1); PG8_BAR; PG8_SCHED;
            } else {
            PG8_LDB(B0, 0, 0); PG8_SCHED; PG8_LDA(At, 0, 0); PG8_STAGE(PG8_SA(1, 1), a1 + hstep, voffA);
            PG8_WAIT_L(8); PG8_BAR; PG8_WAIT_L(0); PG8_MMA(0, 0, At, B0); PG8_BAR; PG8_SCHED;
            PG8_LDB(B1, 0, 1); PG8_STAGE(PG8_SB(0, 0), b2, voffB);
            PG8_BAR; PG8_WAIT_L(0); PG8_MMA(0, 1, At, B1); PG8_BAR;
            PG8_LDA(At, 0, 1); PG8_STAGE(PG8_SA(0, 0), a2, voffA);
            PG8_BAR; PG8_WAIT_L(0); PG8_MMA(1, 0, At, B0); PG8_BAR; PG8_SCHED;
            PG8_STAGE(PG8_SB(0, 1), b2 + hstep, voffB);
            PG8_WAIT_V(6); PG8_BAR; PG8_MMA(1, 1, At, B1); PG8_BAR;
            PG8_LDB(B0, 1, 0); PG8_SCHED; PG8_LDA(At, 1, 0); PG8_STAGE(PG8_SA(0, 1), a2 + hstep, voffA);
            PG8_WAIT_L(8); PG8_BAR; PG8_WAIT_L(0); PG8_MMA(0, 0, At, B0); PG8_BAR; PG8_SCHED;
            PG8_LDB(B1, 1, 1); PG8_STAGE(PG8_SB(1, 0), b3, voffB);
            PG8_BAR; PG8_WAIT_L(0); PG8_MMA(0, 1, At, B1); PG8_BAR;
            PG8_LDA(At, 1, 1); PG8_STAGE(PG8_SA(1, 0), a3, voffA);
            PG8_BAR; PG8_WAIT_L(0); PG8_MMA(1, 0, At, B0); PG8_BAR; PG8_SCHED;
            PG8_STAGE(PG8_SB(1, 1), b3 + hstep, voffB);
            PG8_WAIT_V(6); PG8_BAR; PG8_MMA(1, 1, At, B1); PG8_BAR;
            }
        }
        if constexpr (ALIGN_EPI) { if (wr == 0) PG8_BAR; }
        if constexpr (!Epi::AFTER_DRAIN) { E(acc, cur, wr, wc, fr, fq); S.done(cur); }
        if (!has_next) break;
#pragma unroll
        for (int a = 0; a < 2; ++a)
#pragma unroll
            for (int b = 0; b < 2; ++b)
#pragma unroll
                for (int m = 0; m < 4; ++m)
#pragma unroll
                    for (int n = 0; n < 2; ++n) acc[a][b][m][n] = (f32x4){0.f, 0.f, 0.f, 0.f};
        cur = nxt; cA = nA; cB = nB; ++ui;
        if constexpr (ALIGN_EPI) { if (wr == 1) PG8_BAR; }
    }
    PG8_WAIT_V(0);
    if constexpr (!ALIGN_EPI) { if (wr == 0) PG8_BAR; }
    PG8_BAR;
    if constexpr (Epi::AFTER_DRAIN) { E.fused(acc, cur, wr, wc, fr, fq, lds, wid, lane); S.done(cur); }
#undef PG8_SA
#undef PG8_SB
#undef PG8_STAGE
#undef PG8_LDA
#undef PG8_LDB
#undef PG8_MMA
#undef PG8_WAIT_V
#undef PG8_WAIT_L
#undef PG8_BAR
#undef PG8_SCHED
}
}
constexpr int NWAVES = 8, NTHREADS = NWAVES * 64;
constexpr int BATCH = 8, SEQ = 2048, D = 1024, M = BATCH * SEQ;
constexpr int DCONV = 512, DRWKV = 512, HEADS = 8, HD = 64;
constexpr int DIN = 3328;
constexpr int ZR = 1536, ZK = 2048, ZV = 2560, ZLO = 3072;
constexpr int NE = 32, NG = 4, EPG = 8, DE = 256;
constexpr int MAXSLOTS = 41216;
constexpr float RMS_EPS = 1e-6f, LN_X_EPS = 64e-5f;
#ifndef MK_N_LAUNCHES
#define MK_N_LAUNCHES 10
#endif
constexpr int NPHASES = 10;
constexpr size_t MiB = 1u << 20;
constexpr size_t WS_CTL = 0, CTL_ZERO_BYTES = 64 * 1024;
constexpr size_t WS_WRT = 1 * MiB;
constexpr size_t WS_TOK = 1 * MiB + 256 * 1024;
constexpr size_t WS_WIN = 2 * MiB, WS_WOUT = 9 * MiB;
constexpr size_t WS_XN = 12 * MiB, WS_AUX0 = 12 * MiB, WS_Z = 44 * MiB, WS_Y = 148 * MiB, WS_AUX1 = 180 * MiB, WS_AUX2 = 212 * MiB;
constexpr size_t WS_WGU = 12 * MiB, WS_WD = 44 * MiB, WS_XS = 60 * MiB, WS_HID = 141 * MiB, WS_SOUT = 162 * MiB, WS_END = 244 * MiB;
static_assert(WS_WIN + (size_t)DIN * D * 2 <= WS_WOUT && WS_WOUT + (size_t)D * D * 2 <= WS_XN, "ws map");
static_assert(WS_XS + (size_t)MAXSLOTS * D * 2 <= WS_HID && WS_HID + (size_t)MAXSLOTS * DE * 2 <= WS_SOUT && WS_SOUT + (size_t)MAXSLOTS * D * 2 <= WS_END, "ws map");
static_assert(WS_Z + (size_t)M * DIN * 2 <= WS_Y, "ws map");
constexpr int CW_TMO = 0, CW_BAR = 1024, CW_CNT = 8192;
constexpr int RING_BYTES = 131072, MISC_OFF = RING_BYTES + 320, OFFS_OFF = MISC_OFF + 128, LDS_BYTES = 147456;

#define GAS __attribute__((address_space(1)))
#define LAS __attribute__((address_space(3)))
typedef unsigned short bf16;
typedef unsigned v4u __attribute__((ext_vector_type(4)));
typedef unsigned v2u __attribute__((ext_vector_type(2)));
typedef float f32x4 __attribute__((ext_vector_type(4)));
typedef unsigned short us4 __attribute__((ext_vector_type(4)));
#define LDS_WAIT() asm volatile("s_waitcnt lgkmcnt(0)" ::: "memory")
__device__ __forceinline__ unsigned f2bf(float f) { unsigned u = __builtin_bit_cast(unsigned, f); return (u + 0x7fffu + ((u >> 16) & 1u)) >> 16; }
__device__ __forceinline__ unsigned pk2(float lo, float hi) { return f2bf(lo) | (f2bf(hi) << 16); }
__device__ __forceinline__ float bf2f(unsigned short b) { return __builtin_bit_cast(float, (unsigned)b << 16); }
__device__ __forceinline__ float sigmoid_f(float x) { return 1.0f / (1.0f + __expf(-x)); }

#define XB_TMO      128
#define XB_XCNT(j)  (256  + 64 * (j))
#define XB_XSUB(j)  (1280 + 64 * (j))
#define XB_XGEN(j)  (2304 + 64 * (j))
#define XB_TOP      3328
#define XB_TOPGEN   3392
#define XCD_BAR_WORDS 3456
#define XB_SPIN_CAP (1u << 18)
__device__ __forceinline__ unsigned xb_ld(unsigned* p)              { return __hip_atomic_load(p, __ATOMIC_RELAXED, __HIP_MEMORY_SCOPE_AGENT); }
__device__ __forceinline__ unsigned xb_add(unsigned* p, unsigned v) { return __hip_atomic_fetch_add(p, v, __ATOMIC_RELAXED, __HIP_MEMORY_SCOPE_AGENT); }
__device__ __forceinline__ unsigned xb_xcc_id() { return (unsigned)__builtin_amdgcn_s_getreg((3 << 11) | 20) & 0xFu; }
#define XB_SPIN(cond, bar) do { unsigned _sp = 0; while (cond) { __builtin_amdgcn_s_sleep(1); \
    if ((++_sp & 255u) == 0u) { if (xb_ld(&(bar)[XB_TMO])) break; if (_sp > XB_SPIN_CAP) { atomicAdd(&(bar)[XB_TMO], 1u); break; } } } } while (0)
struct XcdBarrier { unsigned* bar; unsigned x; volatile LAS unsigned* st; };
__device__ __forceinline__ XcdBarrier xcd_barrier_post(unsigned* bar, volatile LAS unsigned* st) {
    XcdBarrier b; b.bar = bar; b.x = xb_xcc_id(); b.st = st;
    if (threadIdx.x == 0) (void)xb_add(&bar[XB_XCNT(b.x)], 1u);
    return b;
}
__device__ __forceinline__ void xcd_barrier_complete(unsigned* bar, unsigned x, unsigned& nloc, unsigned& nx) {
    const unsigned G = gridDim.x * gridDim.y * gridDim.z;
    unsigned sum, cnt, mine, sp = 0u;
    for (;;) {
        sum = 0u; cnt = 0u; mine = 0u;
#pragma unroll
        for (unsigned j = 0; j < 16; ++j) { const unsigned c = xb_ld(&bar[XB_XCNT(j)]); sum += c; cnt += (c > 0u) ? 1u : 0u; mine = (j == x) ? c : mine; }
        if (sum == G) break;
        __builtin_amdgcn_s_sleep(1);
        if ((++sp & 255u) == 0u) { if (xb_ld(&bar[XB_TMO])) break; if (sp > XB_SPIN_CAP) { atomicAdd(&bar[XB_TMO], 1u); break; } }
    }
    nloc = mine > 0u ? mine : 1u; nx = cnt > 0u ? cnt : 1u;
}
__device__ __forceinline__ void xcd_barrier(const XcdBarrier& b) {
    asm volatile("s_waitcnt vmcnt(0)" ::: "memory");
    __syncthreads();
    if (threadIdx.x == 0) {
        unsigned* bar = b.bar;
        __builtin_amdgcn_s_waitcnt(0);
        unsigned nloc = b.st[0], nx = b.st[1];
        if (nloc == 0u) { xcd_barrier_complete(bar, b.x, nloc, nx); b.st[0] = nloc; b.st[1] = nx; }
        const unsigned old = xb_add(&bar[XB_XSUB(b.x)], 1u);
        const unsigned gen = old / nloc;
        if (old + 1u == (gen + 1u) * nloc) {
            __builtin_amdgcn_fence(__ATOMIC_RELEASE, "agent");
            asm volatile("s_waitcnt vmcnt(0)" ::: "memory");
            const unsigned og = xb_add(&bar[XB_TOP], 1u);
            const unsigned tg = og / nx;
            if (og + 1u == (tg + 1u) * nx) xb_add(&bar[XB_TOPGEN], 1u);
            else XB_SPIN(xb_ld(&bar[XB_TOPGEN]) == tg, bar);
            __builtin_amdgcn_fence(__ATOMIC_ACQUIRE, "agent");
            xb_add(&bar[XB_XGEN(b.x)], 1u);
            asm volatile("s_waitcnt vmcnt(0)" ::: "memory");
        } else {
            XB_SPIN(xb_ld(&bar[XB_XGEN(b.x)]) == gen, bar);
            __builtin_amdgcn_fence(__ATOMIC_ACQUIRE, "agent");
            asm volatile("s_waitcnt vmcnt(0)" ::: "memory");
        }
    }
    __syncthreads();
}

struct Args { const float* in[25]; float* out; unsigned char* ws; int ph_lo, ph_hi; };
struct Frame {
    LAS unsigned char* lds;
    int tid, lane, wave, G;
    unsigned* ctl;
};
enum InIdx { I_X = 0, I_G1, I_WIN, I_MU, I_CONVW, I_DECUP, I_DECBASE, I_AUP, I_ABASE, I_GUP, I_KK, I_KA, I_RK, I_LNW, I_LNB, I_WOUT, I_GFFN, I_RGW, I_RGB, I_REW, I_REB, I_EWG, I_EWU, I_EWD, I_GFIN };

__device__ __forceinline__ float wave_sum(float v) {
#pragma unroll
    for (int o = 1; o < 64; o <<= 1) v += __shfl_xor(v, o);
    return v;
}
__device__ __forceinline__ float sum16(float v) { v += __shfl_xor(v, 1); v += __shfl_xor(v, 2); v += __shfl_xor(v, 4); v += __shfl_xor(v, 8); return v; }
__device__ __forceinline__ float sum8(float v) { v += __shfl_xor(v, 1); v += __shfl_xor(v, 2); v += __shfl_xor(v, 4); return v; }

__device__ __forceinline__ void transpose_item(const float* W, int N, int k0, int n0, bf16* WT, int ldk, int drow0, LAS float* scr, int lane) {
#pragma unroll 8
    for (int i = 0; i < 32; ++i) { const int kk = 2 * i + (lane >> 5); scr[kk * 33 + (lane & 31)] = W[(size_t)(k0 + kk) * N + n0 + (lane & 31)]; }
    LDS_WAIT(); asm volatile("" ::: "memory");
    const int c = lane & 7;
#pragma unroll
    for (int j = 0; j < 4; ++j) { const int n = (lane >> 3) + 8 * j; const LAS float* s = scr + (8 * c) * 33 + n;
        v4u o; o.x = pk2(s[0 * 33], s[1 * 33]); o.y = pk2(s[2 * 33], s[3 * 33]); o.z = pk2(s[4 * 33], s[5 * 33]); o.w = pk2(s[6 * 33], s[7 * 33]);
        *(v4u*)(WT + (size_t)(drow0 + n) * ldk + k0 + 8 * c) = o; }
    LDS_WAIT(); asm volatile("" ::: "memory");
}

__device__ __forceinline__ void p0_prologue(const Frame& F, const Args& A) {
    LAS float* scr = (LAS float*)(F.lds + F.wave * 16384);
    const int gw = blockIdx.x * NWAVES + F.wave, NGW = F.G * NWAVES;
    bf16* WinT = (bf16*)(A.ws + WS_WIN); bf16* WoutT = (bf16*)(A.ws + WS_WOUT);
    constexpr int I_IN = (D / 64) * (DIN / 32), I_OUT = (D / 64) * (D / 32);
    for (int it = gw; it < I_IN + I_OUT; it += NGW) {
        if (it < I_IN) { const int kb = it / (DIN / 32), nb = it % (DIN / 32); transpose_item(A.in[I_WIN], DIN, 64 * kb, 32 * nb, WinT, D, 32 * nb, scr, F.lane); }
        else { const int r = it - I_IN, kb = r / (D / 32), nb = r % (D / 32); transpose_item(A.in[I_WOUT], D, 64 * kb, 32 * nb, WoutT, D, 32 * nb, scr, F.lane); }
    }
    { float* WrT = (float*)(A.ws + WS_WRT);
      for (int i = blockIdx.x * NTHREADS + F.tid; i < 36 * D; i += F.G * NTHREADS) { const int n = i / D, k = i % D;
          WrT[i] = (n < NG) ? A.in[I_RGW][k * NG + n] : A.in[I_REW][k * NE + (n - NG)]; } }
    bf16* XN = (bf16*)(A.ws + WS_XN);
    const f32x4* g4 = (const f32x4*)A.in[I_G1] + F.lane;
    for (int m = gw; m < M; m += NGW) {
        const f32x4* xr = (const f32x4*)(A.in[I_X] + (size_t)m * D) + F.lane;
        f32x4 v[4]; float s = 0.f;
#pragma unroll
        for (int j = 0; j < 4; ++j) { v[j] = xr[64 * j]; s += (v[j].x * v[j].x + v[j].y * v[j].y) + (v[j].z * v[j].z + v[j].w * v[j].w); }
        const float rs = rsqrtf(wave_sum(s) * (1.f / D) + RMS_EPS);
        v2u* o8 = (v2u*)(XN + (size_t)m * D) + F.lane;
#pragma unroll
        for (int j = 0; j < 4; ++j) { const f32x4 g = g4[64 * j]; v2u o; o.x = pk2(v[j].x * rs * g.x, v[j].y * rs * g.y); o.y = pk2(v[j].z * rs * g.z, v[j].w * rs * g.w); o8[64 * j] = o; }
    }
}

template <int KLEN> __device__ __forceinline__ void lora_pass(const LAS float* lin, const float* Wc, float (&acc)[32]) {
#pragma unroll
    for (int t = 0; t < 32; ++t) acc[t] = 0.f;
    for (int k4 = 0; k4 < KLEN / 4; ++k4) {
        const float w0 = Wc[(size_t)(4 * k4 + 0) * 512], w1 = Wc[(size_t)(4 * k4 + 1) * 512], w2 = Wc[(size_t)(4 * k4 + 2) * 512], w3 = Wc[(size_t)(4 * k4 + 3) * 512];
#pragma unroll
        for (int t = 0; t < 32; ++t) { const f32x4 l = *(const LAS f32x4*)(lin + t * 256 + 4 * k4); acc[t] += (l.x * w0 + l.y * w1) + (l.z * w2 + l.w * w3); }
    }
}
__device__ __forceinline__ void p2_mixprep(const Frame& F, const Args& A) {
    LAS float* lin = (LAS float*)F.lds;
    const bf16* Z = (const bf16*)(A.ws + WS_Z); bf16* Y = (bf16*)(A.ws + WS_Y);
    float* A0 = (float*)(A.ws + WS_AUX0); float* A1 = (float*)(A.ws + WS_AUX1); float* A2 = (float*)(A.ws + WS_AUX2);
    const int c = F.tid;
    for (int it = blockIdx.x; it < M / 32; it += F.G) {
        const int m0 = it * 32, ts0 = m0 % SEQ;
        {
            const float w0 = A.in[I_CONVW][c], w1 = A.in[I_CONVW][512 + c], w2 = A.in[I_CONVW][1024 + c];
            float ch2 = 0.f, ch1 = 0.f;
            if (ts0 != 0) { const bf16* zp = Z + (size_t)(m0 - 2) * DIN; ch2 = bf2f(zp[512 + c]) * bf2f(zp[1024 + c]); ch1 = bf2f(zp[DIN + 512 + c]) * bf2f(zp[DIN + 1024 + c]); }
            for (int i = 0; i < 32; ++i) { const bf16* zr = Z + (size_t)(m0 + i) * DIN; const float bg = bf2f(zr[c]), ch0 = bf2f(zr[512 + c]) * bf2f(zr[1024 + c]);
                Y[(size_t)(m0 + i) * D + c] = (bf16)f2bf(bg * (w0 * ch2 + w1 * ch1 + w2 * ch0)); ch2 = ch1; ch1 = ch0; }
        }
        {
            const int j = F.tid & 255, hf = F.tid >> 8; const float mu = A.in[I_MU][1536 + j];
            for (int i = 0; i < 16; ++i) { const int tok = hf + 2 * i, m = m0 + tok; const float zc = bf2f(Z[(size_t)m * DIN + ZLO + j]);
                const float zp = (ts0 + tok > 0) ? bf2f(Z[(size_t)(m - 1) * DIN + ZLO + j]) : 0.f; const float zs = zc + (zp - zc) * mu;
                lin[tok * 256 + j] = (j < 64) ? tanhf(zs) : ((j < 128) ? zs : sigmoid_f(zs)); }
        }
        __syncthreads();
        float acc[32];
        lora_pass<64>(lin, A.in[I_DECUP] + c, acc);
        { const float base = A.in[I_DECBASE][c];
#pragma unroll
          for (int t = 0; t < 32; ++t) A0[(size_t)(m0 + t) * 512 + c] = __expf(-0.6065306597126334f * sigmoid_f(base + acc[t])); }
        lora_pass<64>(lin + 64, A.in[I_AUP] + c, acc);
        { const float base = A.in[I_ABASE][c];
#pragma unroll
          for (int t = 0; t < 32; ++t) A1[(size_t)(m0 + t) * 512 + c] = sigmoid_f(base + acc[t]); }
        lora_pass<128>(lin + 128, A.in[I_GUP] + c, acc);
#pragma unroll
        for (int t = 0; t < 32; ++t) A2[(size_t)(m0 + t) * 512 + c] = acc[t];
        __syncthreads();
    }
}

__device__ __forceinline__ void p3_rwkv(const Frame& F, const Args& A) {
    LAS float* KKs = (LAS float*)F.lds; LAS float* Ws = KKs + 2048; LAS float* Bs = KKs + 4096; LAS float* Ks = KKs + 6144; LAS float* Rs = KKs + 8192; LAS float* Vs = KKs + 10240;
    LAS float* Os = KKs + 12288; LAS float* BON = KKs + 14336;
    const bf16* Z = (const bf16*)(A.ws + WS_Z); bf16* Y = (bf16*)(A.ws + WS_Y);
    const float* A0 = (const float*)(A.ws + WS_AUX0); const float* A1 = (const float*)(A.ws + WS_AUX1); const float* A2 = (const float*)(A.ws + WS_AUX2);
    const int tl = F.tid >> 4, c4 = (F.tid & 15) * 4, row = F.tid >> 3, sub = F.tid & 7;
    for (int item = blockIdx.x; item < BATCH * HEADS; item += F.G) {
        const int b = item / HEADS, h = item % HEADS, hc = h * HD + c4;
        float s[8];
#pragma unroll
        for (int j = 0; j < 8; ++j) s[j] = 0.f;
        const f32x4 mur = *(const f32x4*)(A.in[I_MU] + hc), muk = *(const f32x4*)(A.in[I_MU] + 512 + hc), muv = *(const f32x4*)(A.in[I_MU] + 1024 + hc);
        const f32x4 kkw = *(const f32x4*)(A.in[I_KK] + hc), kaw = *(const f32x4*)(A.in[I_KA] + hc), rkw = *(const f32x4*)(A.in[I_RK] + hc);
        const f32x4 lnw = *(const f32x4*)(A.in[I_LNW] + hc), lnb = *(const f32x4*)(A.in[I_LNB] + hc);
        for (int chunk = 0; chunk < SEQ / 32; ++chunk) {
            const int t = chunk * 32 + tl, m = b * SEQ + t;
            {
                const bf16* zr = Z + (size_t)m * DIN;
                const us4 rc = *(const us4*)(zr + ZR + hc), kc = *(const us4*)(zr + ZK + hc), vc = *(const us4*)(zr + ZV + hc);
                us4 rp = {0, 0, 0, 0}, kp = rp, vp = rp;
                if (t > 0) { rp = *(const us4*)(zr - DIN + ZR + hc); kp = *(const us4*)(zr - DIN + ZK + hc); vp = *(const us4*)(zr - DIN + ZV + hc); }
                const f32x4 av = *(const f32x4*)(A1 + (size_t)m * 512 + hc), dv = *(const f32x4*)(A0 + (size_t)m * 512 + hc);
                f32x4 r4, k4, v4, kk4, kp4; float ss = 0.f, bd = 0.f;
#pragma unroll
                for (int q = 0; q < 4; ++q) { const float rcq = bf2f(rc[q]), kcq = bf2f(kc[q]), vcq = bf2f(vc[q]);
                    r4[q] = rcq + (bf2f(rp[q]) - rcq) * mur[q]; k4[q] = kcq + (bf2f(kp[q]) - kcq) * muk[q]; v4[q] = vcq + (bf2f(vp[q]) - vcq) * muv[q];
                    kk4[q] = k4[q] * kkw[q]; ss += kk4[q] * kk4[q]; kp4[q] = k4[q] * (1.0f + (av[q] - 1.0f) * kaw[q]); bd += r4[q] * kp4[q] * rkw[q]; }
                ss = sum16(ss); bd = sum16(bd);
                const float inv = 1.0f / fmaxf(sqrtf(ss), 1e-12f);
                f32x4 b4;
#pragma unroll
                for (int q = 0; q < 4; ++q) { kk4[q] *= inv; b4[q] = kk4[q] * av[q]; }
                *(LAS f32x4*)(KKs + tl * 64 + c4) = kk4; *(LAS f32x4*)(Ws + tl * 64 + c4) = dv; *(LAS f32x4*)(Bs + tl * 64 + c4) = b4;
                *(LAS f32x4*)(Ks + tl * 64 + c4) = kp4; *(LAS f32x4*)(Rs + tl * 64 + c4) = r4; *(LAS f32x4*)(Vs + tl * 64 + c4) = v4;
                if ((F.tid & 15) == 0) BON[tl] = bd;
            }
            __syncthreads();
            for (int tt = 0; tt < 32; ++tt) {
                const f32x4 ka = *(const LAS f32x4*)(KKs + tt * 64 + sub * 8), kb = *(const LAS f32x4*)(KKs + tt * 64 + sub * 8 + 4);
                const f32x4 wa = *(const LAS f32x4*)(Ws + tt * 64 + sub * 8), wb = *(const LAS f32x4*)(Ws + tt * 64 + sub * 8 + 4);
                const f32x4 ba = *(const LAS f32x4*)(Bs + tt * 64 + sub * 8), bb = *(const LAS f32x4*)(Bs + tt * 64 + sub * 8 + 4);
                const f32x4 qa = *(const LAS f32x4*)(Ks + tt * 64 + sub * 8), qb = *(const LAS f32x4*)(Ks + tt * 64 + sub * 8 + 4);
                const f32x4 ra = *(const LAS f32x4*)(Rs + tt * 64 + sub * 8), rb = *(const LAS f32x4*)(Rs + tt * 64 + sub * 8 + 4);
                const float vv = Vs[tt * 64 + row];
                float d = 0.f;
#pragma unroll
                for (int j = 0; j < 4; ++j) d += s[j] * ka[j] + s[4 + j] * kb[j];
                d = -sum8(d);
                float o = 0.f;
#pragma unroll
                for (int j = 0; j < 4; ++j) { s[j] = s[j] * wa[j] + d * ba[j] + vv * qa[j]; s[4 + j] = s[4 + j] * wb[j] + d * bb[j] + vv * qb[j]; o += s[j] * ra[j] + s[4 + j] * rb[j]; }
                o = sum8(o);
                if (sub == 0) Os[tt * 64 + row] = o;
            }
            __syncthreads();
            {
                const f32x4 o4 = *(const LAS f32x4*)(Os + tl * 64 + c4), v4 = *(const LAS f32x4*)(Vs + tl * 64 + c4);
                const float mean = sum16((o4.x + o4.y) + (o4.z + o4.w)) * (1.f / 64.f);
                const f32x4 dd = o4 - mean;
                const float var = sum16((dd.x * dd.x + dd.y * dd.y) + (dd.z * dd.z + dd.w * dd.w)) * (1.f / 64.f);
                const float rstd = rsqrtf(var + LN_X_EPS), bon = BON[tl];
                const f32x4 g4 = *(const f32x4*)(A2 + (size_t)m * 512 + hc);
                float yv[4];
#pragma unroll
                for (int q = 0; q < 4; ++q) yv[q] = (dd[q] * rstd * lnw[q] + lnb[q] + bon * v4[q]) * g4[q];
                v2u o; o.x = pk2(yv[0], yv[1]); o.y = pk2(yv[2], yv[3]);
                *(v2u*)(Y + (size_t)m * D + DCONV + hc) = o;
            }
            __syncthreads();
        }
    }
}
__device__ __forceinline__ void p5_router(const Frame& F, const Args& A) {
    const int gw = blockIdx.x * NWAVES + F.wave, NGW = F.G * NWAVES;
    const float* H1 = A.out; const float* WrT = (const float*)(A.ws + WS_WRT);
    int* tok_e = (int*)(A.ws + WS_TOK); int* tok_r0 = tok_e + M; int* tok_r1 = tok_e + 2 * M; float* tok_g0 = (float*)(tok_e + 3 * M); float* tok_g1 = (float*)(tok_e + 4 * M); float* tok_rs = (float*)(tok_e + 5 * M);
    const f32x4* gf4 = (const f32x4*)A.in[I_GFFN] + F.lane;
    for (int m = gw; m < M; m += NGW) {
        const f32x4* hr = (const f32x4*)(H1 + (size_t)m * D) + F.lane;
        f32x4 v[4]; float s = 0.f;
#pragma unroll
        for (int j = 0; j < 4; ++j) { v[j] = hr[64 * j]; s += (v[j].x * v[j].x + v[j].y * v[j].y) + (v[j].z * v[j].z + v[j].w * v[j].w); }
        const float rs = rsqrtf(wave_sum(s) * (1.f / D) + RMS_EPS);
#pragma unroll
        for (int j = 0; j < 4; ++j) v[j] = v[j] * rs * gf4[64 * j];
        LAS float* lsc = (LAS float*)(F.lds + F.wave * 16384);
#pragma unroll 2
        for (int n = 0; n < 36; ++n) { const f32x4* w = (const f32x4*)(WrT + (size_t)n * D) + F.lane; float p = 0.f;
#pragma unroll
            for (int j = 0; j < 4; ++j) { const f32x4 ww = w[64 * j]; p += (v[j].x * ww.x + v[j].y * ww.y) + (v[j].z * ww.z + v[j].w * ww.w); }
            p = wave_sum(p); if (F.lane == 0) lsc[n] = p; }
        LDS_WAIT(); asm volatile("" ::: "memory");
        float lg[36];
#pragma unroll
        for (int n = 0; n < 36; ++n) lg[n] = lsc[n];
        LDS_WAIT(); asm volatile("" ::: "memory");
#pragma unroll
        for (int n = 0; n < NG; ++n) lg[n] += A.in[I_RGB][n];
#pragma unroll
        for (int n = 0; n < NE; ++n) lg[NG + n] += A.in[I_REB][n];
        float gmax = lg[0]; int gi = 0;
#pragma unroll
        for (int j = 1; j < NG; ++j) if (lg[j] > gmax) { gmax = lg[j]; gi = j; }
        float gsum = 0.f;
#pragma unroll
        for (int j = 0; j < NG; ++j) gsum += __expf(lg[j] - gmax);
        const float gprob = 1.0f / gsum;
        float ig[EPG];
#pragma unroll
        for (int j = 0; j < EPG; ++j) ig[j] = (gi == 0) ? lg[NG + j] : ((gi == 1) ? lg[NG + 8 + j] : ((gi == 2) ? lg[NG + 16 + j] : lg[NG + 24 + j]));
        float l0 = ig[0]; int i0 = 0;
#pragma unroll
        for (int j = 1; j < EPG; ++j) if (ig[j] > l0) { l0 = ig[j]; i0 = j; }
        float l1 = -3.0e38f; int i1 = 0;
#pragma unroll
        for (int j = 0; j < EPG; ++j) if (j != i0 && ig[j] > l1) { l1 = ig[j]; i1 = j; }
        const float p0 = 1.0f / (1.0f + __expf(l1 - l0)), p1 = 1.0f - p0;
        if (F.lane == 0) {
            const int e0 = gi * EPG + i0, e1 = gi * EPG + i1;
            const int r0 = (int)atomicAdd(F.ctl + CW_CNT + 64 * e0, 1u), r1 = (int)atomicAdd(F.ctl + CW_CNT + 64 * e1, 1u);
            tok_e[m] = e0 | (e1 << 8); tok_r0[m] = r0; tok_r1[m] = r1; tok_g0[m] = gprob * p0; tok_g1[m] = gprob * p1; tok_rs[m] = rs;
        }
    }
    LAS float* scr = (LAS float*)(F.lds + F.wave * 16384);
    bf16* WGU = (bf16*)(A.ws + WS_WGU); bf16* WDt = (bf16*)(A.ws + WS_WD);
    constexpr int IPE = (D / 64) * (DE / 32);
    for (int it = gw; it < 3 * NE * IPE; it += NGW) {
        const int which = it / (NE * IPE), r = it % (NE * IPE), e = r / IPE, q = r % IPE;
        if (which < 2) { const int kb = q / (DE / 32), nb = q % (DE / 32), n0 = 32 * nb;
            transpose_item(A.in[which == 0 ? I_EWG : I_EWU] + (size_t)e * D * DE, DE, 64 * kb, n0, WGU, D, e * 512 + 256 * (n0 >> 7) + (n0 & 127) + (which == 1 ? 128 : 0), scr, F.lane); }
        else { const int kb = q / (D / 32), nb = q % (D / 32);
            transpose_item(A.in[I_EWD] + (size_t)e * DE * D, D, 64 * kb, 32 * nb, WDt, DE, e * D + 32 * nb, scr, F.lane); }
    }
}
__device__ __forceinline__ void load_offsets(const Frame& F, const Args& A) {
    LAS int* offs = (LAS int*)(F.lds + OFFS_OFF);
    if (F.tid == 0) { int o = 0;
        for (int e = 0; e < NE; ++e) { offs[e] = o; const int c = (int)__hip_atomic_load(F.ctl + CW_CNT + 64 * e, __ATOMIC_RELAXED, __HIP_MEMORY_SCOPE_AGENT); o += (c + 255) & ~255; }
        offs[NE] = o; }
    __syncthreads();
}
__device__ __forceinline__ void p6a_gather(const Frame& F, const Args& A) {
    load_offsets(F, A);
    const LAS int* offs = (const LAS int*)(F.lds + OFFS_OFF);
    const int gw = blockIdx.x * NWAVES + F.wave, NGW = F.G * NWAVES;
    const float* H1 = A.out; bf16* XS = (bf16*)(A.ws + WS_XS);
    const int* tok_e = (const int*)(A.ws + WS_TOK); const int* tok_r0 = tok_e + M; const int* tok_r1 = tok_e + 2 * M; const float* tok_rs = (const float*)(tok_e + 5 * M);
    int* tok_s0 = (int*)(A.ws + WS_TOK) + 6 * M; int* tok_s1 = tok_s0 + M;
    const f32x4* gf4 = (const f32x4*)A.in[I_GFFN] + F.lane;
    for (int m = gw; m < M; m += NGW) {
        const int ee = tok_e[m], e0 = ee & 255, e1 = (ee >> 8) & 255;
        const int s0 = offs[e0] + tok_r0[m], s1 = offs[e1] + tok_r1[m];
        const float rs = tok_rs[m];
        const f32x4* hr = (const f32x4*)(H1 + (size_t)m * D) + F.lane;
        v2u* o0 = (v2u*)(XS + (size_t)s0 * D) + F.lane; v2u* o1 = (v2u*)(XS + (size_t)s1 * D) + F.lane;
#pragma unroll
        for (int j = 0; j < 4; ++j) { const f32x4 v = hr[64 * j] * rs * gf4[64 * j]; v2u o; o.x = pk2(v.x, v.y); o.y = pk2(v.z, v.w); o0[64 * j] = o; o1[64 * j] = o; }
        if (F.lane == 0) { tok_s0[m] = s0; tok_s1[m] = s1; }
    }
}
__device__ __forceinline__ void p7_final(const Frame& F, const Args& A) {
    const int gw = blockIdx.x * NWAVES + F.wave, NGW = F.G * NWAVES;
    const bf16* SO = (const bf16*)(A.ws + WS_SOUT);
    const int* tok_e = (const int*)(A.ws + WS_TOK); const float* tok_g0 = (const float*)(tok_e + 3 * M); const float* tok_g1 = (const float*)(tok_e + 4 * M);
    const int* tok_s0 = tok_e + 6 * M; const int* tok_s1 = tok_s0 + M;
    const f32x4* gf4 = (const f32x4*)A.in[I_GFIN] + F.lane;
    for (int m = gw; m < M; m += NGW) {
        const int s0 = tok_s0[m], s1 = tok_s1[m]; const float g0 = tok_g0[m], g1 = tok_g1[m];
        f32x4* hr = (f32x4*)(A.out + (size_t)m * D) + F.lane;
        const v2u* a0 = (const v2u*)(SO + (size_t)s0 * D) + F.lane; const v2u* a1 = (const v2u*)(SO + (size_t)s1 * D) + F.lane;
        f32x4 v[4]; float s = 0.f;
#pragma unroll
        for (int j = 0; j < 4; ++j) { const v2u x0 = a0[64 * j], x1 = a1[64 * j]; f32x4 h = hr[64 * j];
            h.x += g0 * bf2f((unsigned short)(x0.x & 0xffffu)) + g1 * bf2f((unsigned short)(x1.x & 0xffffu)); h.y += g0 * bf2f((unsigned short)(x0.x >> 16)) + g1 * bf2f((unsigned short)(x1.x >> 16));
            h.z += g0 * bf2f((unsigned short)(x0.y & 0xffffu)) + g1 * bf2f((unsigned short)(x1.y & 0xffffu)); h.w += g0 * bf2f((unsigned short)(x0.y >> 16)) + g1 * bf2f((unsigned short)(x1.y >> 16));
            v[j] = h; s += (h.x * h.x + h.y * h.y) + (h.z * h.z + h.w * h.w); }
        const float rs = rsqrtf(wave_sum(s) * (1.f / D) + RMS_EPS);
#pragma unroll
        for (int j = 0; j < 4; ++j) hr[64 * j] = v[j] * rs * gf4[64 * j];
    }
}

__global__ void __launch_bounds__(NTHREADS, 2) fwd_kernel(Args args) {
    extern __shared__ __attribute__((aligned(16))) unsigned char lds_raw[];
    Frame F;
    F.lds = (LAS unsigned char*)lds_raw;
    F.tid = threadIdx.x; F.lane = F.tid & 63; F.wave = __builtin_amdgcn_readfirstlane(F.tid >> 6); F.G = gridDim.x;
    F.ctl = (unsigned*)(args.ws + WS_CTL);
    const Args& A = args;
    volatile LAS unsigned* MISC = (volatile LAS unsigned*)(F.lds + MISC_OFF);
    for (int u = F.tid; u < (LDS_BYTES - RING_BYTES) / 4; u += NTHREADS) ((LAS unsigned*)(F.lds + RING_BYTES))[u] = 0u;
    __syncthreads();
    const int lo = args.ph_lo, hi = args.ph_hi;
    XcdBarrier bar; bar.bar = F.ctl + CW_BAR; bar.x = 0; bar.st = nullptr;
    if (hi - lo > 1) bar = xcd_barrier_post(F.ctl + CW_BAR, MISC + 8);
#define IN(k) (lo <= (k) && (k) < hi)
#ifndef PH_MASK
#define PH_MASK 0x3ff
#endif
#define PH_EN(k) (((PH_MASK) >> (k)) & 1)
#define SEAM(k) do { if (IN(k) && IN((k) + 1)) xcd_barrier(bar); } while (0)
    if (PH_EN(0) && IN(0)) { p0_prologue(F, A); } SEAM(0);
    if (PH_EN(1) && IN(1)) {
        pg8::Gemm g{(const pg8::bf16_t*)(A.ws + WS_XN), (const pg8::bf16_t*)(A.ws + WS_WIN), M, DIN, D}; pg8::StaticOrder S; S.init(M, DIN, F.G, (int)blockIdx.x);
        pg8::EpiBf16<0> E{(pg8::bf16_t*)(A.ws + WS_Z), DIN, nullptr, 0, 0, 1.f};
        pg8::gemm_phase<pg8::EpiBf16<0>, pg8::StaticOrder, true, true>(F.lds, g, S, E);
    } SEAM(1);
    if (PH_EN(2) && IN(2)) { p2_mixprep(F, A); } SEAM(2);
    if (PH_EN(3) && IN(3)) { p3_rwkv(F, A); } SEAM(3);
    if (PH_EN(4) && IN(4)) {
        pg8::Gemm g{(const pg8::bf16_t*)(A.ws + WS_Y), (const pg8::bf16_t*)(A.ws + WS_WOUT), M, D, D}; pg8::StaticOrder S; S.init(M, D, F.G, (int)blockIdx.x);
        pg8::EpiResF32 E{A.in[I_X], A.out, D};
        pg8::gemm_phase<pg8::EpiResF32, pg8::StaticOrder, true, true>(F.lds, g, S, E);
    } SEAM(4);
    if (PH_EN(5) && IN(5)) { p5_router(F, A); } SEAM(5);
    if (PH_EN(6) && IN(6)) { p6a_gather(F, A); } SEAM(6);
    if (PH_EN(7) && IN(7)) {
        load_offsets(F, A);
        pg8::Gemm g{(const pg8::bf16_t*)(A.ws + WS_XS), (const pg8::bf16_t*)(A.ws + WS_WGU), MAXSLOTS, 512, D};
        pg8::MoeOrder S; S.init((const LAS int*)(F.lds + OFFS_OFF), 2, F.G, (int)blockIdx.x, (size_t)512 * D * 2);
        pg8::EpiSwiGLU E{(pg8::bf16_t*)(A.ws + WS_HID), DE};
        pg8::gemm_phase<pg8::EpiSwiGLU, pg8::MoeOrder, true, true>(F.lds, g, S, E);
    } SEAM(7);
    if (PH_EN(8) && IN(8)) {
        load_offsets(F, A);
        pg8::Gemm g{(const pg8::bf16_t*)(A.ws + WS_HID), (const pg8::bf16_t*)(A.ws + WS_WD), MAXSLOTS, D, DE};
        pg8::MoeOrder S; S.init((const LAS int*)(F.lds + OFFS_OFF), 4, F.G, (int)blockIdx.x, (size_t)D * DE * 2);
        pg8::EpiBf16<0> E{(pg8::bf16_t*)(A.ws + WS_SOUT), D, nullptr, 0, 0, 1.f};
        pg8::gemm_phase<pg8::EpiBf16<0>, pg8::MoeOrder, true, true>(F.lds, g, S, E);
    } SEAM(8);
    if (PH_EN(9) && IN(9)) { p7_final(F, A); }
#undef IN
#undef SEAM
}

extern "C" void kernel_launch(void* const* d_in, const int* in_sizes, int n_in, void* d_out, int out_size, void* d_ws, size_t ws_size, hipStream_t stream) {
    static int grid = 0;
    if (grid == 0) {
        if (n_in != 25 || in_sizes[0] != M * D || out_size != M * D || ws_size < WS_END) { fprintf(stderr, "kernel_launch: unexpected shapes (n_in %d, in0 %d, out %d, ws %zu)\n", n_in, n_in > 0 ? in_sizes[0] : -1, out_size, ws_size); grid = -1; return; }
        int dev = 0, cus = 0, per_cu = 0;
        if (hipGetDevice(&dev) != hipSuccess || hipDeviceGetAttribute(&cus, hipDeviceAttributeMultiprocessorCount, dev) != hipSuccess) { grid = -1; return; }
        if (hipFuncSetAttribute((const void*)fwd_kernel, hipFuncAttributeMaxDynamicSharedMemorySize, LDS_BYTES) != hipSuccess) { fprintf(stderr, "kernel_launch: hipFuncSetAttribute failed\n"); grid = -1; return; }
        if (hipOccupancyMaxActiveBlocksPerMultiprocessor(&per_cu, (const void*)fwd_kernel, NTHREADS, LDS_BYTES) != hipSuccess || per_cu < 1) { fprintf(stderr, "kernel_launch: occupancy query says %d blocks per CU\n", per_cu); per_cu = 1; }
        (void)hipGetLastError();
        grid = cus;
    }
    if (grid < 0) return;
    (void)hipMemsetAsync((char*)d_ws + WS_CTL, 0, CTL_ZERO_BYTES, stream);
    Args a{};
    for (int i = 0; i < 25; ++i) a.in[i] = (const float*)d_in[i];
    a.out = (float*)d_out; a.ws = (unsigned char*)d_ws;
#if MK_N_LAUNCHES == 1
    a.ph_lo = 0; a.ph_hi = NPHASES;
    void* kargs[] = {&a};
    hipError_t e = hipLaunchCooperativeKernel((const void*)fwd_kernel, dim3(grid), dim3(NTHREADS), kargs, LDS_BYTES, stream);
    if (e != hipSuccess) fprintf(stderr, "kernel_launch: cooperative launch failed: %s (grid %d)\n", hipGetErrorString(e), grid);
#else
    for (int p = 0; p < NPHASES; ++p) { a.ph_lo = p; a.ph_hi = p + 1; hipLaunchKernelGGL(fwd_kernel, dim3(grid), dim3(NTHREADS), LDS_BYTES, stream, a); }
#endif
}
```

```cpp
#include <hip/hip_runtime.h>
#include <cstdio>
#include <cstdint>
namespace pg8 {
#define PG8_LAS __attribute__((address_space(3)))
typedef unsigned short bf16_t;
typedef short bf16x8 __attribute__((ext_vector_type(8)));
typedef float f32x4 __attribute__((ext_vector_type(4)));
typedef unsigned u32x4 __attribute__((ext_vector_type(4)));
constexpr int BM = 256, BK = 64, HALF = 128, HTB = HALF * BK * 2  , STAGE_BYTES = 8 * HTB, NXCD = 8, WGM = 8;

__host__ __device__ __forceinline__ int lds_byte(int r, int c) { const int st = (r >> 4) * 2 + (c >> 5), rr = r & 15, cc = c & 31, ob = rr * 64 + cc * 2; return st * 1024 + (ob ^ (((ob >> 9) & 1) << 5)); }
__host__ __device__ __forceinline__ void stage_rc(int b, int& R, int& C) { const int st = b / 1024, sb = b % 1024, swz = sb ^ (((sb >> 9) & 1) << 5); R = (st >> 1) * 16 + swz / 64; C = (st & 1) * 32 + (swz % 64) / 2; }
__host__ __device__ __forceinline__ int perm32(int rho) { const int n = rho >> 4, i = rho & 15; return 8 * (i >> 2) + 4 * n + (i & 3); }


struct Unit { int pm, pn, e; };
struct Gemm { const bf16_t* A; const bf16_t* Bt; int M, N, K; };

struct StaticOrder {
    int nM, nN, nwg, G, c;
    __host__ __device__ void init(int M, int N, int G_, int c_) { nM = M / BM; nN = N / BM; nwg = nM * nN; G = G_; c = c_; }
    __host__ __device__ bool next(int i, Unit& u) const {
        const long L = (long)i * G + c; if (L >= nwg) return false;
        int wgid = (int)L; { const int q = nwg / NXCD, r = nwg % NXCD, xcd = wgid % NXCD, off = wgid / NXCD; wgid = (xcd < r ? xcd * (q + 1) : r * (q + 1) + (xcd - r) * q) + off; }
        const int nig = WGM * nN, gid = wgid / nig, fm = gid * WGM, gsz = (nM - fm) < WGM ? (nM - fm) : WGM;
        u.pm = fm + ((wgid % nig) % gsz); u.pn = (wgid % nig) / gsz; u.e = 0; return true;
    }
    __device__ __forceinline__ const char* a_ptr(const Gemm& g, const Unit& u, size_t tstep) const { return (const char*)g.A + (size_t)u.pm * tstep; }
    __device__ __forceinline__ const char* b_ptr(const Gemm& g, const Unit& u, size_t tstep) const { return (const char*)g.Bt + (size_t)u.pn * tstep; }
    __device__ __forceinline__ void a_ready(const Unit&) const {}
    __device__ __forceinline__ void done(const Unit&) const {}
};
struct MoeOrder {
    const PG8_LAS int* off; int nct, nunits, G, c; size_t estride;
    __device__ __forceinline__ void init(const PG8_LAS int* off_, int nct_, int G_, int c_, size_t estride_) {
        off = off_; nct = nct_; G = G_; c = c_; estride = estride_; nunits = __builtin_amdgcn_readfirstlane((off_[32] >> 8) * nct_); }
    __device__ __forceinline__ bool next(int i, Unit& u) const {
        const int L = i * G + c; if (L >= nunits) return false;
        const int rt = L / nct, ct = L - rt * nct, pos = rt << 8; int e = 0;
#pragma unroll
        for (int j = 1; j < 32; ++j) e += (off[j] <= pos) ? 1 : 0;
        u.pm = rt; u.pn = ct; u.e = __builtin_amdgcn_readfirstlane(e); return true;
    }
    __device__ __forceinline__ const char* a_ptr(const Gemm& g, const Unit& u, size_t tstep) const { return (const char*)g.A + (size_t)u.pm * tstep; }
    __device__ __forceinline__ const char* b_ptr(const Gemm& g, const Unit& u, size_t tstep) const { return (const char*)g.Bt + (size_t)u.e * estride + (size_t)u.pn * tstep; }
    __device__ __forceinline__ void a_ready(const Unit&) const {}
    __device__ __forceinline__ void done(const Unit&) const {}
};

__device__ __forceinline__ unsigned cvt_pk_bf16(float lo, float hi) { unsigned r; asm volatile("v_cvt_pk_bf16_f32 %0, %1, %2" : "=v"(r) : "v"(lo), "v"(hi)); return r; }
template <int ACT  > struct EpiBf16 {
    static constexpr bool PERM = true, AFTER_DRAIN = false; static_assert(ACT == 0, "EpiBf16: ACT is 0 (none)");
    bf16_t* O; int ldc; const float* bias; int split_cols; size_t split_stride; float scale0;
    __device__ __forceinline__ void operator()(const f32x4 (&acc)[2][2][4][2], const Unit& u, int wr, int wc, int fr, int fq) const {
        const int row0 = u.pm * BM + wr * 64 + fr; int colt = u.pn * BM; bf16_t* base = O;
        float sc = 1.f; if (split_cols) { const int t = colt / split_cols; base += (size_t)t * split_stride; colt -= t * split_cols; if (t == 0) sc = scale0; }
        const int col0 = colt + wc * 32 + 8 * fq, bcol0 = u.pn * BM + wc * 32 + 8 * fq;
        f32x4 bv[2][2];
#pragma unroll
        for (int bj = 0; bj < 2; ++bj)
#pragma unroll
            for (int n = 0; n < 2; ++n) bv[bj][n] = bias ? *(const f32x4*)(bias + bcol0 + bj * HALF + 4 * n) : (f32x4){0.f, 0.f, 0.f, 0.f};
#pragma unroll
        for (int ai = 0; ai < 2; ++ai)
#pragma unroll
            for (int m = 0; m < 4; ++m) { bf16_t* rowp = base + (size_t)(row0 + ai * HALF + m * 16) * ldc + col0;
#pragma unroll
                for (int bj = 0; bj < 2; ++bj) { f32x4 v0 = acc[ai][bj][m][0] + bv[bj][0], v1 = acc[ai][bj][m][1] + bv[bj][1];
                    v0 = v0 * sc; v1 = v1 * sc; u32x4 w; w.x = cvt_pk_bf16(v0[0], v0[1]); w.y = cvt_pk_bf16(v0[2], v0[3]); w.z = cvt_pk_bf16(v1[0], v1[1]); w.w = cvt_pk_bf16(v1[2], v1[3]);
                    *(u32x4*)(rowp + bj * HALF) = w; } }
    }
};
struct EpiResF32 {
    static constexpr bool PERM = false, AFTER_DRAIN = false;
    const float* base; float* C; int ldc;
    __device__ __forceinline__ void operator()(const f32x4 (&acc)[2][2][4][2], const Unit& u, int wr, int wc, int fr, int fq) const {
        const int row0 = u.pm * BM + wr * 64 + fr, col0 = u.pn * BM + wc * 32 + 4 * fq;
#pragma unroll
        for (int ai = 0; ai < 2; ++ai)
#pragma unroll
            for (int m = 0; m < 4; ++m) { const size_t o = (size_t)(row0 + ai * HALF + m * 16) * ldc + col0;
#pragma unroll
                for (int bj = 0; bj < 2; ++bj)
#pragma unroll
                    for (int n = 0; n < 2; ++n) *(f32x4*)(C + o + bj * HALF + n * 16) = acc[ai][bj][m][n] + *(const f32x4*)(base + o + bj * HALF + n * 16); }
    }
};
__device__ __forceinline__ float silu_f(float x) { return x * __builtin_amdgcn_rcpf(1.0f + __builtin_amdgcn_exp2f(-1.4426950408889634f * x)); }
struct EpiSwiGLU {
    static constexpr bool PERM = true, AFTER_DRAIN = false;
    bf16_t* H; int ldc;
    __device__ __forceinline__ void operator()(const f32x4 (&acc)[2][2][4][2], const Unit& u, int wr, int wc, int fr, int fq) const {
        const int row0 = u.pm * BM + wr * 64 + fr, col0 = u.pn * HALF + wc * 32 + 8 * fq;
#pragma unroll
        for (int ai = 0; ai < 2; ++ai)
#pragma unroll
            for (int m = 0; m < 4; ++m) { bf16_t* rowp = H + (size_t)(row0 + ai * HALF + m * 16) * ldc + col0;
                const f32x4 g0 = acc[ai][0][m][0], g1 = acc[ai][0][m][1], u0 = acc[ai][1][m][0], u1 = acc[ai][1][m][1];
                u32x4 w; w.x = cvt_pk_bf16(silu_f(g0[0]) * u0[0], silu_f(g0[1]) * u0[1]); w.y = cvt_pk_bf16(silu_f(g0[2]) * u0[2], silu_f(g0[3]) * u0[3]);
                w.z = cvt_pk_bf16(silu_f(g1[0]) * u1[0], silu_f(g1[1]) * u1[1]); w.w = cvt_pk_bf16(silu_f(g1[2]) * u1[2], silu_f(g1[3]) * u1[3]);
                *(u32x4*)rowp = w; }
    }
};

template <class Epi, class Sched, bool ALIGN_EPI = false, bool SP2 = false>
__device__ __forceinline__ void gemm_phase(PG8_LAS unsigned char* lds, const Gemm g, const Sched& S, const Epi& E) {
    const int tid = threadIdx.x, wid = __builtin_amdgcn_readfirstlane(tid >> 6), lane = tid & 63, wr = wid >> 2, wc = wid & 3, fr = lane & 15, fq = lane >> 4;
    const int K = g.K, nt = K / BK;
    unsigned voffA[2], voffB[2];
#pragma unroll
    for (int i = 0; i < 2; ++i) { int R, C; stage_rc(tid * 16 + i * 8192, R, C); const int Rb = Epi::PERM ? ((R & ~31) + perm32(R & 31)) : R;
        voffA[i] = (unsigned)(R * K + C) * 2u; voffB[i] = (unsigned)(Rb * K + C) * 2u; }
    const size_t kstep = (size_t)(BK * 2);
    const size_t hstep = (size_t)HALF * K * 2;
    const size_t tstep = 2 * hstep;
    const unsigned ldsw = (unsigned)wid * 1024u;
    const int aoff = lds_byte(wr * 64 + fr, fq * 8), boff = lds_byte(wc * 32 + fr, fq * 8);
#define PG8_SA(b, h) (((b) * 2 + (h)) * HTB)
#define PG8_SB(b, h) ((4 + (b) * 2 + (h)) * HTB)
#define PG8_STAGE(bufoff, gbase, voff) do { _Pragma("unroll") for (int _i = 0; _i < 2; ++_i) \
        __builtin_amdgcn_global_load_lds((const unsigned*)((const char*)(gbase) + (voff)[_i]), (PG8_LAS unsigned*)(lds + (bufoff) + ldsw + _i * 8192), 16, 0, 0); } while (0)
#define PG8_LDA(dst, b, h) do { _Pragma("unroll") for (int m = 0; m < 4; ++m) _Pragma("unroll") for (int k = 0; k < 2; ++k) dst[m][k] = *(const PG8_LAS bf16x8*)(lds + PG8_SA(b, h) + aoff + m * 2048 + k * 1024); } while (0)
#define PG8_LDB(dst, b, h) do { _Pragma("unroll") for (int n = 0; n < 2; ++n) _Pragma("unroll") for (int k = 0; k < 2; ++k) dst[n][k] = *(const PG8_LAS bf16x8*)(lds + PG8_SB(b, h) + boff + n * 2048 + k * 1024); } while (0)
#define PG8_MMA(ai, bj, At, Bt) do { __builtin_amdgcn_s_setprio(1); _Pragma("unroll") for (int m = 0; m < 4; ++m) _Pragma("unroll") for (int n = 0; n < 2; ++n) _Pragma("unroll") for (int k = 0; k < 2; ++k) \
        acc[ai][bj][m][n] = __builtin_amdgcn_mfma_f32_16x16x32_bf16(Bt[n][k], At[m][k], acc[ai][bj][m][n], 0, 0, 0); __builtin_amdgcn_s_setprio(0); } while (0)
#define PG8_WAIT_V(n) asm volatile("s_waitcnt vmcnt(" #n ")" ::: "memory")
#define PG8_WAIT_L(n) asm volatile("s_waitcnt lgkmcnt(" #n ")" ::: "memory")
#define PG8_BAR __builtin_amdgcn_s_barrier()
#define PG8_SCHED __builtin_amdgcn_sched_barrier(0)
    Unit cur, nxt; int ui = 0;
    if (!S.next(0, cur)) return;
    f32x4 acc[2][2][4][2];
#pragma unroll
    for (int a = 0; a < 2; ++a)
#pragma unroll
        for (int b = 0; b < 2; ++b)
#pragma unroll
            for (int m = 0; m < 4; ++m)
#pragma unroll
                for (int n = 0; n < 2; ++n) acc[a][b][m][n] = (f32x4){0.f, 0.f, 0.f, 0.f};
    bf16x8 At[4][2], B0[2][2], B1[2][2];
    const char* cA = S.a_ptr(g, cur, tstep); const char* cB = S.b_ptr(g, cur, tstep);
    S.a_ready(cur);
    if constexpr (SP2) {
        PG8_STAGE(PG8_SB(0, 0), cB, voffB); PG8_STAGE(PG8_SB(0, 1), cB + hstep, voffB); PG8_STAGE(PG8_SA(0, 0), cA, voffA); PG8_STAGE(PG8_SA(0, 1), cA + hstep, voffA);
        if (wr == 1) PG8_BAR;
        PG8_WAIT_V(2); PG8_BAR;
        PG8_STAGE(PG8_SB(1, 0), cB + kstep, voffB); PG8_STAGE(PG8_SA(1, 0), cA + kstep, voffA); PG8_STAGE(PG8_SB(1, 1), cB + hstep + kstep, voffB);
        PG8_WAIT_V(6); PG8_BAR;
    } else {
        PG8_STAGE(PG8_SB(0, 0), cB, voffB); PG8_STAGE(PG8_SA(0, 0), cA, voffA); PG8_STAGE(PG8_SB(0, 1), cB + hstep, voffB); PG8_STAGE(PG8_SA(0, 1), cA + hstep, voffA);
        if (wr == 1) PG8_BAR;
        PG8_WAIT_V(4); PG8_BAR;
        PG8_STAGE(PG8_SB(1, 0), cB + kstep, voffB); PG8_STAGE(PG8_SA(1, 0), cA + kstep, voffA); PG8_STAGE(PG8_SB(1, 1), cB + hstep + kstep, voffB);
        PG8_WAIT_V(6); PG8_BAR;
    }
    for (;;) {
        const bool has_next = S.next(ui + 1, nxt);
        const char* nA = has_next ? S.a_ptr(g, nxt, tstep) : cA; const char* nB = has_next ? S.b_ptr(g, nxt, tstep) : cB;
        for (int t = 0; t < nt; t += 2) {
            const bool last = (t == nt - 2);
            const char* a1 = cA + (size_t)(t + 1) * kstep;
            const char* a2 = last ? nA : cA + (size_t)(t + 2) * kstep; const char* b2 = last ? nB : cB + (size_t)(t + 2) * kstep;
            const char* a3 = a2 + kstep; const char* b3 = b2 + kstep;
            if (last && has_next) S.a_ready(nxt);
            if constexpr (SP2) {
            PG8_LDB(B0, 0, 0); PG8_LDB(B1, 0, 1); PG8_SCHED; PG8_LDA(At, 0, 0); PG8_STAGE(PG8_SA(1, 1), a1 + hstep, voffA);
            PG8_WAIT_V(8); PG8_WAIT_L(0); PG8_BAR; PG8_MMA(0, 0, At, B0); PG8_MMA(0, 1, At, B1); PG8_BAR; PG8_SCHED;
            PG8_LDA(At, 0, 1); PG8_STAGE(PG8_SB(0, 0), b2, voffB); PG8_STAGE(PG8_SB(0, 1), b2 + hstep, voffB); PG8_STAGE(PG8_SA(0, 0), a2, voffA);
            PG8_WAIT_V(8); PG8_WAIT_L(0); PG8_BAR; PG8_MMA(1, 0, At, B0); PG8_MMA(1, 1, At, B1); PG8_BAR; PG8_SCHED;
            PG8_LDB(B0, 1, 0); PG8_LDB(B1, 1, 1); PG8_SCHED; PG8_LDA(At, 1, 0); PG8_STAGE(PG8_SA(0, 1), a2 + hstep, voffA);
            PG8_WAIT_V(8); PG8_WAIT_L(0); PG8_BAR; PG8_MMA(0, 0, At, B0); PG8_MMA(0, 1, At, B1); PG8_BAR; PG8_SCHED;
            PG8_LDA(At, 1, 1); PG8_STAGE(PG8_SB(1, 0), b3, voffB); PG8_STAGE(PG8_SB(1, 1), b3 + hstep, voffB); PG8_STAGE(PG8_SA(1, 0), a3, voffA);
            PG8_WAIT_V(8); PG8_WAIT_L(0); PG8_BAR; PG8_MMA(1, 0, At, B0); PG8_MMA(1, 1, At, B1); PG8_BAR; PG8_SCHED;
            } else {
            PG8_LDB(B0, 0, 0); PG8_SCHED; PG8_LDA(At, 0, 0); PG8_STAGE(PG8_SA(1, 1), a1 + hstep, voffA);
            PG8_WAIT_L(8); PG8_BAR; PG8_WAIT_L(0); PG8_MMA(0, 0, At, B0); PG8_BAR; PG8_SCHED;
            PG8_LDB(B1, 0, 1); PG8_STAGE(PG8_SB(0, 0), b2, voffB);
            PG8_BAR; PG8_WAIT_L(0); PG8_MMA(0, 1, At, B1); PG8_BAR;
            PG8_LDA(At, 0, 1); PG8_STAGE(PG8_SA(0, 0), a2, voffA);
            PG8_BAR; PG8_WAIT_L(0); PG8_MMA(1, 0, At, B0); PG8_BAR; PG8_SCHED;
            PG8_STAGE(PG8_SB(0, 1), b2 + hstep, voffB);
            PG8_WAIT_V(6); PG8_BAR; PG8_MMA(1, 1, At, B1); PG8_BAR;
            PG8_LDB(B0, 1, 0); PG8_SCHED; PG8_LDA(At, 1, 0); PG8_STAGE(PG8_SA(0, 1), a2 + hstep, voffA);
            PG8_WAIT_L(8); PG8_BAR; PG8_WAIT_L(0); PG8_MMA(0, 0, At, B0); PG8_BAR; PG8_SCHED;
            PG8_LDB(B1, 1, 1); PG8_STAGE(PG8_SB(1, 0), b3, voffB);
            PG8_BAR; PG8_WAIT_L(0); PG8_MMA(0, 1, At, B1); PG8_BAR;
            PG8_LDA(At, 1, 1); PG8_STAGE(PG8_SA(1, 0), a3, voffA);
            PG8_BAR; PG8_WAIT_L(0); PG8_MMA(1, 0, At, B0); PG8_BAR; PG8_SCHED;
            PG8_STAGE(PG8_SB(1, 1), b3 + hstep, voffB);
            PG8_WAIT_V(6); PG8_BAR; PG8_MMA(1, 1, At, B1); PG8_BAR;
            }
        }
        if constexpr (ALIGN_EPI) { if (wr == 0) PG8_BAR; }
        if constexpr (!Epi::AFTER_DRAIN) { E(acc, cur, wr, wc, fr, fq); S.done(cur); }
        if (!has_next) break;
#pragma unroll
        for (int a = 0; a < 2; ++a)
#pragma unroll
            for (int b = 0; b < 2; ++b)
#pragma unroll
                for (int m = 0; m < 4; ++m)
#pragma unroll
                    for (int n = 0; n < 2; ++n) acc[a][b][m][n] = (f32x4){0.f, 0.f, 0.f, 0.f};
        cur = nxt; cA = nA; cB = nB; ++ui;
        if constexpr (ALIGN_EPI) { if (wr == 1) PG8_BAR; }
    }
    PG8_WAIT_V(0);
    if constexpr (!ALIGN_EPI) { if (wr == 0) PG8_BAR; }
    PG8_BAR;
    if constexpr (Epi::AFTER_DRAIN) { E.fused(acc, cur, wr, wc, fr, fq, lds, wid, lane); S.done(cur); }
#undef PG8_SA
#undef PG8_SB
#undef PG8_STAGE
#undef PG8_LDA
#undef PG8_LDB
#undef PG8_MMA
#undef PG8_WAIT_V
#undef PG8_WAIT_L
#undef PG8_BAR
#undef PG8_SCHED
}
}
constexpr int NWAVES = 8, NTHREADS = NWAVES * 64;
constexpr int BATCH = 8, SEQ = 2048, D = 1024, M = BATCH * SEQ;
constexpr int DCONV = 512, DRWKV = 512, HEADS = 8, HD = 64;
constexpr int DIN = 3328;
constexpr int ZR = 1536, ZK = 2048, ZV = 2560, ZLO = 3072;
constexpr int NE = 32, NG = 4, EPG = 8, DE = 256;
constexpr int MAXSLOTS = 41216;
constexpr float RMS_EPS = 1e-6f, LN_X_EPS = 64e-5f;
#ifndef MK_N_LAUNCHES
#define MK_N_LAUNCHES 1
#endif
constexpr int NPHASES = 10;
constexpr size_t MiB = 1u << 20;
constexpr size_t WS_CTL = 0, CTL_ZERO_BYTES = 64 * 1024;
constexpr size_t WS_WRT = 1 * MiB;
constexpr size_t WS_TOK = 1 * MiB + 256 * 1024;
constexpr size_t WS_WIN = 2 * MiB, WS_WOUT = 9 * MiB;
constexpr size_t WS_XN = 12 * MiB, WS_AUX0 = 12 * MiB, WS_Z = 44 * MiB, WS_Y = 148 * MiB, WS_AUX1 = 180 * MiB, WS_AUX2 = 212 * MiB;
constexpr size_t WS_WGU = 12 * MiB, WS_WD = 44 * MiB, WS_XS = 60 * MiB, WS_HID = 141 * MiB, WS_SOUT = 162 * MiB, WS_END = 244 * MiB;
static_assert(WS_WIN + (size_t)DIN * D * 2 <= WS_WOUT && WS_WOUT + (size_t)D * D * 2 <= WS_XN, "ws map");
static_assert(WS_XS + (size_t)MAXSLOTS * D * 2 <= WS_HID && WS_HID + (size_t)MAXSLOTS * DE * 2 <= WS_SOUT && WS_SOUT + (size_t)MAXSLOTS * D * 2 <= WS_END, "ws map");
static_assert(WS_Z + (size_t)M * DIN * 2 <= WS_Y, "ws map");
constexpr int CW_TMO = 0, CW_BAR = 1024, CW_CNT = 8192;
constexpr int RING_BYTES = 131072, MISC_OFF = RING_BYTES + 320, OFFS_OFF = MISC_OFF + 128, LDS_BYTES = 147456;

#define GAS __attribute__((address_space(1)))
#define LAS __attribute__((address_space(3)))
typedef unsigned short bf16;
typedef unsigned v4u __attribute__((ext_vector_type(4)));
typedef unsigned v2u __attribute__((ext_vector_type(2)));
typedef float f32x4 __attribute__((ext_vector_type(4)));
typedef unsigned short us4 __attribute__((ext_vector_type(4)));
#define LDS_WAIT() asm volatile("s_waitcnt lgkmcnt(0)" ::: "memory")
__device__ __forceinline__ unsigned f2bf(float f) { unsigned u = __builtin_bit_cast(unsigned, f); return (u + 0x7fffu + ((u >> 16) & 1u)) >> 16; }
__device__ __forceinline__ unsigned pk2(float lo, float hi) { return f2bf(lo) | (f2bf(hi) << 16); }
__device__ __forceinline__ float bf2f(unsigned short b) { return __builtin_bit_cast(float, (unsigned)b << 16); }
__device__ __forceinline__ float sigmoid_f(float x) { return 1.0f / (1.0f + __expf(-x)); }

#define XB_TMO      128
#define XB_XCNT(j)  (256  + 64 * (j))
#define XB_XSUB(j)  (1280 + 64 * (j))
#define XB_XGEN(j)  (2304 + 64 * (j))
#define XB_TOP      3328
#define XB_TOPGEN   3392
#define XCD_BAR_WORDS 3456
#define XB_SPIN_CAP (1u << 18)
__device__ __forceinline__ unsigned xb_ld(unsigned* p)              { return __hip_atomic_load(p, __ATOMIC_RELAXED, __HIP_MEMORY_SCOPE_AGENT); }
__device__ __forceinline__ unsigned xb_add(unsigned* p, unsigned v) { return __hip_atomic_fetch_add(p, v, __ATOMIC_RELAXED, __HIP_MEMORY_SCOPE_AGENT); }
__device__ __forceinline__ unsigned xb_xcc_id() { return (unsigned)__builtin_amdgcn_s_getreg((3 << 11) | 20) & 0xFu; }
#define XB_SPIN(cond, bar) do { unsigned _sp = 0; while (cond) { __builtin_amdgcn_s_sleep(1); \
    if ((++_sp & 255u) == 0u) { if (xb_ld(&(bar)[XB_TMO])) break; if (_sp > XB_SPIN_CAP) { atomicAdd(&(bar)[XB_TMO], 1u); break; } } } } while (0)
struct XcdBarrier { unsigned* bar; unsigned x; volatile LAS unsigned* st; };
__device__ __forceinline__ XcdBarrier xcd_barrier_post(unsigned* bar, volatile LAS unsigned* st) {
    XcdBarrier b; b.bar = bar; b.x = xb_xcc_id(); b.st = st;
    if (threadIdx.x == 0) (void)xb_add(&bar[XB_XCNT(b.x)], 1u);
    return b;
}
__device__ __forceinline__ void xcd_barrier_complete(unsigned* bar, unsigned x, unsigned& nloc, unsigned& nx) {
    const unsigned G = gridDim.x * gridDim.y * gridDim.z;
    unsigned sum, cnt, mine, sp = 0u;
    for (;;) {
        sum = 0u; cnt = 0u; mine = 0u;
#pragma unroll
        for (unsigned j = 0; j < 16; ++j) { const unsigned c = xb_ld(&bar[XB_XCNT(j)]); sum += c; cnt += (c > 0u) ? 1u : 0u; mine = (j == x) ? c : mine; }
        if (sum == G) break;
        __builtin_amdgcn_s_sleep(1);
        if ((++sp & 255u) == 0u) { if (xb_ld(&bar[XB_TMO])) break; if (sp > XB_SPIN_CAP) { atomicAdd(&bar[XB_TMO], 1u); break; } }
    }
    nloc = mine > 0u ? mine : 1u; nx = cnt > 0u ? cnt : 1u;
}
__device__ __forceinline__ void xcd_barrier(const XcdBarrier& b) {
    asm volatile("s_waitcnt vmcnt(0)" ::: "memory");
    __syncthreads();
    if (threadIdx.x == 0) {
        unsigned* bar = b.bar;
        __builtin_amdgcn_s_waitcnt(0);
        unsigned nloc = b.st[0], nx = b.st[1];
        if (nloc == 0u) { xcd_barrier_complete(bar, b.x, nloc, nx); b.st[0] = nloc; b.st[1] = nx; }
        const unsigned old = xb_add(&bar[XB_XSUB(b.x)], 1u);
        const unsigned gen = old / nloc;
        if (old + 1u == (gen + 1u) * nloc) {
            __builtin_amdgcn_fence(__ATOMIC_RELEASE, "agent");
            asm volatile("s_waitcnt vmcnt(0)" ::: "memory");
            const unsigned og = xb_add(&bar[XB_TOP], 1u);
            const unsigned tg = og / nx;
            if (og + 1u == (tg + 1u) * nx) xb_add(&bar[XB_TOPGEN], 1u);
            else XB_SPIN(xb_ld(&bar[XB_TOPGEN]) == tg, bar);
            __builtin_amdgcn_fence(__ATOMIC_ACQUIRE, "agent");
            xb_add(&bar[XB_XGEN(b.x)], 1u);
            asm volatile("s_waitcnt vmcnt(0)" ::: "memory");
        } else {
            XB_SPIN(xb_ld(&bar[XB_XGEN(b.x)]) == gen, bar);
            __builtin_amdgcn_fence(__ATOMIC_ACQUIRE, "agent");
            asm volatile("s_waitcnt vmcnt(0)" ::: "memory");
        }
    }
    __syncthreads();
}

struct Args { const float* in[25]; float* out; unsigned char* ws; int ph_lo, ph_hi; };
struct Frame {
    LAS unsigned char* lds;
    int tid, lane, wave, G;
    unsigned* ctl;
};
enum InIdx { I_X = 0, I_G1, I_WIN, I_MU, I_CONVW, I_DECUP, I_DECBASE, I_AUP, I_ABASE, I_GUP, I_KK, I_KA, I_RK, I_LNW, I_LNB, I_WOUT, I_GFFN, I_RGW, I_RGB, I_REW, I_REB, I_EWG, I_EWU, I_EWD, I_GFIN };

__device__ __forceinline__ float wave_sum(float v) {
#pragma unroll
    for (int o = 1; o < 64; o <<= 1) v += __shfl_xor(v, o);
    return v;
}
__device__ __forceinline__ float sum16(float v) { v += __shfl_xor(v, 1); v += __shfl_xor(v, 2); v += __shfl_xor(v, 4); v += __shfl_xor(v, 8); return v; }
__device__ __forceinline__ float sum8(float v) { v += __shfl_xor(v, 1); v += __shfl_xor(v, 2); v += __shfl_xor(v, 4); return v; }

__device__ __forceinline__ void transpose_item(const float* W, int N, int k0, int n0, bf16* WT, int ldk, int drow0, LAS float* scr, int lane) {
#pragma unroll 8
    for (int i = 0; i < 32; ++i) { const int kk = 2 * i + (lane >> 5); scr[kk * 33 + (lane & 31)] = W[(size_t)(k0 + kk) * N + n0 + (lane & 31)]; }
    LDS_WAIT(); asm volatile("" ::: "memory");
    const int c = lane & 7;
#pragma unroll
    for (int j = 0; j < 4; ++j) { const int n = (lane >> 3) + 8 * j; const LAS float* s = scr + (8 * c) * 33 + n;
        v4u o; o.x = pk2(s[0 * 33], s[1 * 33]); o.y = pk2(s[2 * 33], s[3 * 33]); o.z = pk2(s[4 * 33], s[5 * 33]); o.w = pk2(s[6 * 33], s[7 * 33]);
        *(v4u*)(WT + (size_t)(drow0 + n) * ldk + k0 + 8 * c) = o; }
    LDS_WAIT(); asm volatile("" ::: "memory");
}

__device__ __forceinline__ void p0_prologue(const Frame& F, const Args& A) {
    LAS float* scr = (LAS float*)(F.lds + F.wave * 16384);
    const int gw = blockIdx.x * NWAVES + F.wave, NGW = F.G * NWAVES;
    bf16* WinT = (bf16*)(A.ws + WS_WIN); bf16* WoutT = (bf16*)(A.ws + WS_WOUT);
    constexpr int I_IN = (D / 64) * (DIN / 32), I_OUT = (D / 64) * (D / 32);
    for (int it = gw; it < I_IN + I_OUT; it += NGW) {
        if (it < I_IN) { const int kb = it / (DIN / 32), nb = it % (DIN / 32); transpose_item(A.in[I_WIN], DIN, 64 * kb, 32 * nb, WinT, D, 32 * nb, scr, F.lane); }
        else { const int r = it - I_IN, kb = r / (D / 32), nb = r % (D / 32); transpose_item(A.in[I_WOUT], D, 64 * kb, 32 * nb, WoutT, D, 32 * nb, scr, F.lane); }
    }
    { float* WrT = (float*)(A.ws + WS_WRT);
      for (int i = blockIdx.x * NTHREADS + F.tid; i < 36 * D; i += F.G * NTHREADS) { const int n = i / D, k = i % D;
          WrT[i] = (n < NG) ? A.in[I_RGW][k * NG + n] : A.in[I_REW][k * NE + (n - NG)]; } }
    bf16* XN = (bf16*)(A.ws + WS_XN);
    const f32x4* g4 = (const f32x4*)A.in[I_G1] + F.lane;
    for (int m = gw; m < M; m += NGW) {
        const f32x4* xr = (const f32x4*)(A.in[I_X] + (size_t)m * D) + F.lane;
        f32x4 v[4]; float s = 0.f;
#pragma unroll
        for (int j = 0; j < 4; ++j) { v[j] = xr[64 * j]; s += (v[j].x * v[j].x + v[j].y * v[j].y) + (v[j].z * v[j].z + v[j].w * v[j].w); }
        const float rs = rsqrtf(wave_sum(s) * (1.f / D) + RMS_EPS);
        v2u* o8 = (v2u*)(XN + (size_t)m * D) + F.lane;
#pragma unroll
        for (int j = 0; j < 4; ++j) { const f32x4 g = g4[64 * j]; v2u o; o.x = pk2(v[j].x * rs * g.x, v[j].y * rs * g.y); o.y = pk2(v[j].z * rs * g.z, v[j].w * rs * g.w); o8[64 * j] = o; }
    }
}

template <int KLEN> __device__ __forceinline__ void lora_pass(const LAS float* lin, const float* Wc, float (&acc)[32]) {
#pragma unroll
    for (int t = 0; t < 32; ++t) acc[t] = 0.f;
    for (int k4 = 0; k4 < KLEN / 4; ++k4) {
        const float w0 = Wc[(size_t)(4 * k4 + 0) * 512], w1 = Wc[(size_t)(4 * k4 + 1) * 512], w2 = Wc[(size_t)(4 * k4 + 2) * 512], w3 = Wc[(size_t)(4 * k4 + 3) * 512];
#pragma unroll
        for (int t = 0; t < 32; ++t) { const f32x4 l = *(const LAS f32x4*)(lin + t * 256 + 4 * k4); acc[t] += (l.x * w0 + l.y * w1) + (l.z * w2 + l.w * w3); }
    }
}
__device__ __forceinline__ void p2_mixprep(const Frame& F, const Args& A) {
    LAS float* lin = (LAS float*)F.lds;
    const bf16* Z = (const bf16*)(A.ws + WS_Z); bf16* Y = (bf16*)(A.ws + WS_Y);
    float* A0 = (float*)(A.ws + WS_AUX0); float* A1 = (float*)(A.ws + WS_AUX1); float* A2 = (float*)(A.ws + WS_AUX2);
    const int c = F.tid;
    for (int it = blockIdx.x; it < M / 32; it += F.G) {
        const int m0 = it * 32, ts0 = m0 % SEQ;
        {
            const float w0 = A.in[I_CONVW][c], w1 = A.in[I_CONVW][512 + c], w2 = A.in[I_CONVW][1024 + c];
            float ch2 = 0.f, ch1 = 0.f;
            if (ts0 != 0) { const bf16* zp = Z + (size_t)(m0 - 2) * DIN; ch2 = bf2f(zp[512 + c]) * bf2f(zp[1024 + c]); ch1 = bf2f(zp[DIN + 512 + c]) * bf2f(zp[DIN + 1024 + c]); }
            for (int i = 0; i < 32; ++i) { const bf16* zr = Z + (size_t)(m0 + i) * DIN; const float bg = bf2f(zr[c]), ch0 = bf2f(zr[512 + c]) * bf2f(zr[1024 + c]);
                Y[(size_t)(m0 + i) * D + c] = (bf16)f2bf(bg * (w0 * ch2 + w1 * ch1 + w2 * ch0)); ch2 = ch1; ch1 = ch0; }
        }
        {
            const int j = F.tid & 255, hf = F.tid >> 8; const float mu = A.in[I_MU][1536 + j];
            for (int i = 0; i < 16; ++i) { const int tok = hf + 2 * i, m = m0 + tok; const float zc = bf2f(Z[(size_t)m * DIN + ZLO + j]);
                const float zp = (ts0 + tok > 0) ? bf2f(Z[(size_t)(m - 1) * DIN + ZLO + j]) : 0.f; const float zs = zc + (zp - zc) * mu;
                lin[tok * 256 + j] = (j < 64) ? tanhf(zs) : ((j < 128) ? zs : sigmoid_f(zs)); }
        }
        __syncthreads();
        float acc[32];
        lora_pass<64>(lin, A.in[I_DECUP] + c, acc);
        { const float base = A.in[I_DECBASE][c];
#pragma unroll
          for (int t = 0; t < 32; ++t) A0[(size_t)(m0 + t) * 512 + c] = __expf(-0.6065306597126334f * sigmoid_f(base + acc[t])); }
        lora_pass<64>(lin + 64, A.in[I_AUP] + c, acc);
        { const float base = A.in[I_ABASE][c];
#pragma unroll
          for (int t = 0; t < 32; ++t) A1[(size_t)(m0 + t) * 512 + c] = sigmoid_f(base + acc[t]); }
        lora_pass<128>(lin + 128, A.in[I_GUP] + c, acc);
#pragma unroll
        for (int t = 0; t < 32; ++t) A2[(size_t)(m0 + t) * 512 + c] = acc[t];
        __syncthreads();
    }
}

__device__ __forceinline__ void p3_rwkv(const Frame& F, const Args& A) {
    LAS float* KKs = (LAS float*)F.lds; LAS float* Ws = KKs + 2048; LAS float* Bs = KKs + 4096; LAS float* Ks = KKs + 6144; LAS float* Rs = KKs + 8192; LAS float* Vs = KKs + 10240;
    LAS float* Os = KKs + 12288; LAS float* BON = KKs + 14336;
    const bf16* Z = (const bf16*)(A.ws + WS_Z); bf16* Y = (bf16*)(A.ws + WS_Y);
    const float* A0 = (const float*)(A.ws + WS_AUX0); const float* A1 = (const float*)(A.ws + WS_AUX1); const float* A2 = (const float*)(A.ws + WS_AUX2);
    const int tl = F.tid >> 4, c4 = (F.tid & 15) * 4, row = F.tid >> 3, sub = F.tid & 7;
    for (int item = blockIdx.x; item < BATCH * HEADS; item += F.G) {
        const int b = item / HEADS, h = item % HEADS, hc = h * HD + c4;
        float s[8];
#pragma unroll
        for (int j = 0; j < 8; ++j) s[j] = 0.f;
        const f32x4 mur = *(const f32x4*)(A.in[I_MU] + hc), muk = *(const f32x4*)(A.in[I_MU] + 512 + hc), muv = *(const f32x4*)(A.in[I_MU] + 1024 + hc);
        const f32x4 kkw = *(const f32x4*)(A.in[I_KK] + hc), kaw = *(const f32x4*)(A.in[I_KA] + hc), rkw = *(const f32x4*)(A.in[I_RK] + hc);
        const f32x4 lnw = *(const f32x4*)(A.in[I_LNW] + hc), lnb = *(const f32x4*)(A.in[I_LNB] + hc);
        for (int chunk = 0; chunk < SEQ / 32; ++chunk) {
            const int t = chunk * 32 + tl, m = b * SEQ + t;
            {
                const bf16* zr = Z + (size_t)m * DIN;
                const us4 rc = *(const us4*)(zr + ZR + hc), kc = *(const us4*)(zr + ZK + hc), vc = *(const us4*)(zr + ZV + hc);
                us4 rp = {0, 0, 0, 0}, kp = rp, vp = rp;
                if (t > 0) { rp = *(const us4*)(zr - DIN + ZR + hc); kp = *(const us4*)(zr - DIN + ZK + hc); vp = *(const us4*)(zr - DIN + ZV + hc); }
                const f32x4 av = *(const f32x4*)(A1 + (size_t)m * 512 + hc), dv = *(const f32x4*)(A0 + (size_t)m * 512 + hc);
                f32x4 r4, k4, v4, kk4, kp4; float ss = 0.f, bd = 0.f;
#pragma unroll
                for (int q = 0; q < 4; ++q) { const float rcq = bf2f(rc[q]), kcq = bf2f(kc[q]), vcq = bf2f(vc[q]);
                    r4[q] = rcq + (bf2f(rp[q]) - rcq) * mur[q]; k4[q] = kcq + (bf2f(kp[q]) - kcq) * muk[q]; v4[q] = vcq + (bf2f(vp[q]) - vcq) * muv[q];
                    kk4[q] = k4[q] * kkw[q]; ss += kk4[q] * kk4[q]; kp4[q] = k4[q] * (1.0f + (av[q] - 1.0f) * kaw[q]); bd += r4[q] * kp4[q] * rkw[q]; }
                ss = sum16(ss); bd = sum16(bd);
                const float inv = 1.0f / fmaxf(sqrtf(ss), 1e-12f);
                f32x4 b4;
#pragma unroll
                for (int q = 0; q < 4; ++q) { kk4[q] *= inv; b4[q] = kk4[q] * av[q]; }
                *(LAS f32x4*)(KKs + tl * 64 + c4) = kk4; *(LAS f32x4*)(Ws + tl * 64 + c4) = dv; *(LAS f32x4*)(Bs + tl * 64 + c4) = b4;
                *(LAS f32x4*)(Ks + tl * 64 + c4) = kp4; *(LAS f32x4*)(Rs + tl * 64 + c4) = r4; *(LAS f32x4*)(Vs + tl * 64 + c4) = v4;
                if ((F.tid & 15) == 0) BON[tl] = bd;
            }
            __syncthreads();
            for (int tt = 0; tt < 32; ++tt) {
                const f32x4 ka = *(const LAS f32x4*)(KKs + tt * 64 + sub * 8), kb = *(const LAS f32x4*)(KKs + tt * 64 + sub * 8 + 4);
                const f32x4 wa = *(const LAS f32x4*)(Ws + tt * 64 + sub * 8), wb = *(const LAS f32x4*)(Ws + tt * 64 + sub * 8 + 4);
                const f32x4 ba = *(const LAS f32x4*)(Bs + tt * 64 + sub * 8), bb = *(const LAS f32x4*)(Bs + tt * 64 + sub * 8 + 4);
                const f32x4 qa = *(const LAS f32x4*)(Ks + tt * 64 + sub * 8), qb = *(const LAS f32x4*)(Ks + tt * 64 + sub * 8 + 4);
                const f32x4 ra = *(const LAS f32x4*)(Rs + tt * 64 + sub * 8), rb = *(const LAS f32x4*)(Rs + tt * 64 + sub * 8 + 4);
                const float vv = Vs[tt * 64 + row];
                float d = 0.f;
#pragma unroll
                for (int j = 0; j < 4; ++j) d += s[j] * ka[j] + s[4 + j] * kb[j];
                d = -sum8(d);
                float o = 0.f;
#pragma unroll
                for (int j = 0; j < 4; ++j) { s[j] = s[j] * wa[j] + d * ba[j] + vv * qa[j]; s[4 + j] = s[4 + j] * wb[j] + d * bb[j] + vv * qb[j]; o += s[j] * ra[j] + s[4 + j] * rb[j]; }
                o = sum8(o);
                if (sub == 0) Os[tt * 64 + row] = o;
            }
            __syncthreads();
            {
                const f32x4 o4 = *(const LAS f32x4*)(Os + tl * 64 + c4), v4 = *(const LAS f32x4*)(Vs + tl * 64 + c4);
                const float mean = sum16((o4.x + o4.y) + (o4.z + o4.w)) * (1.f / 64.f);
                const f32x4 dd = o4 - mean;
                const float var = sum16((dd.x * dd.x + dd.y * dd.y) + (dd.z * dd.z + dd.w * dd.w)) * (1.f / 64.f);
                const float rstd = rsqrtf(var + LN_X_EPS), bon = BON[tl];
                const f32x4 g4 = *(const f32x4*)(A2 + (size_t)m * 512 + hc);
                float yv[4];
#pragma unroll
                for (int q = 0; q < 4; ++q) yv[q] = (dd[q] * rstd * lnw[q] + lnb[q] + bon * v4[q]) * g4[q];
                v2u o; o.x = pk2(yv[0], yv[1]); o.y = pk2(yv[2], yv[3]);
                *(v2u*)(Y + (size_t)m * D + DCONV + hc) = o;
            }
            __syncthreads();
        }
    }
}
__device__ __forceinline__ void p5_router(const Frame& F, const Args& A) {
    const int gw = blockIdx.x * NWAVES + F.wave, NGW = F.G * NWAVES;
    const float* H1 = A.out; const float* WrT = (const float*)(A.ws + WS_WRT);
    int* tok_e = (int*)(A.ws + WS_TOK); int* tok_r0 = tok_e + M; int* tok_r1 = tok_e + 2 * M; float* tok_g0 = (float*)(tok_e + 3 * M); float* tok_g1 = (float*)(tok_e + 4 * M); float* tok_rs = (float*)(tok_e + 5 * M);
    const f32x4* gf4 = (const f32x4*)A.in[I_GFFN] + F.lane;
    for (int m = gw; m < M; m += NGW) {
        const f32x4* hr = (const f32x4*)(H1 + (size_t)m * D) + F.lane;
        f32x4 v[4]; float s = 0.f;
#pragma unroll
        for (int j = 0; j < 4; ++j) { v[j] = hr[64 * j]; s += (v[j].x * v[j].x + v[j].y * v[j].y) + (v[j].z * v[j].z + v[j].w * v[j].w); }
        const float rs = rsqrtf(wave_sum(s) * (1.f / D) + RMS_EPS);
#pragma unroll
        for (int j = 0; j < 4; ++j) v[j] = v[j] * rs * gf4[64 * j];
        LAS float* lsc = (LAS float*)(F.lds + F.wave * 16384);
#pragma unroll 2
        for (int n = 0; n < 36; ++n) { const f32x4* w = (const f32x4*)(WrT + (size_t)n * D) + F.lane; float p = 0.f;
#pragma unroll
            for (int j = 0; j < 4; ++j) { const f32x4 ww = w[64 * j]; p += (v[j].x * ww.x + v[j].y * ww.y) + (v[j].z * ww.z + v[j].w * ww.w); }
            p = wave_sum(p); if (F.lane == 0) lsc[n] = p; }
        LDS_WAIT(); asm volatile("" ::: "memory");
        float lg[36];
#pragma unroll
        for (int n = 0; n < 36; ++n) lg[n] = lsc[n];
        LDS_WAIT(); asm volatile("" ::: "memory");
#pragma unroll
        for (int n = 0; n < NG; ++n) lg[n] += A.in[I_RGB][n];
#pragma unroll
        for (int n = 0; n < NE; ++n) lg[NG + n] += A.in[I_REB][n];
        float gmax = lg[0]; int gi = 0;
#pragma unroll
        for (int j = 1; j < NG; ++j) if (lg[j] > gmax) { gmax = lg[j]; gi = j; }
        float gsum = 0.f;
#pragma unroll
        for (int j = 0; j < NG; ++j) gsum += __expf(lg[j] - gmax);
        const float gprob = 1.0f / gsum;
        float ig[EPG];
#pragma unroll
        for (int j = 0; j < EPG; ++j) ig[j] = (gi == 0) ? lg[NG + j] : ((gi == 1) ? lg[NG + 8 + j] : ((gi == 2) ? lg[NG + 16 + j] : lg[NG + 24 + j]));
        float l0 = ig[0]; int i0 = 0;
#pragma unroll
        for (int j = 1; j < EPG; ++j) if (ig[j] > l0) { l0 = ig[j]; i0 = j; }
        float l1 = -3.0e38f; int i1 = 0;
#pragma unroll
        for (int j = 0; j < EPG; ++j) if (j != i0 && ig[j] > l1) { l1 = ig[j]; i1 = j; }
        const float p0 = 1.0f / (1.0f + __expf(l1 - l0)), p1 = 1.0f - p0;
        if (F.lane == 0) {
            const int e0 = gi * EPG + i0, e1 = gi * EPG + i1;
            const int r0 = (int)atomicAdd(F.ctl + CW_CNT + 64 * e0, 1u), r1 = (int)atomicAdd(F.ctl + CW_CNT + 64 * e1, 1u);
            tok_e[m] = e0 | (e1 << 8); tok_r0[m] = r0; tok_r1[m] = r1; tok_g0[m] = gprob * p0; tok_g1[m] = gprob * p1; tok_rs[m] = rs;
        }
    }
    LAS float* scr = (LAS float*)(F.lds + F.wave * 16384);
    bf16* WGU = (bf16*)(A.ws + WS_WGU); bf16* WDt = (bf16*)(A.ws + WS_WD);
    constexpr int IPE = (D / 64) * (DE / 32);
    for (int it = gw; it < 3 * NE * IPE; it += NGW) {
        const int which = it / (NE * IPE), r = it % (NE * IPE), e = r / IPE, q = r % IPE;
        if (which < 2) { const int kb = q / (DE / 32), nb = q % (DE / 32), n0 = 32 * nb;
            transpose_item(A.in[which == 0 ? I_EWG : I_EWU] + (size_t)e * D * DE, DE, 64 * kb, n0, WGU, D, e * 512 + 256 * (n0 >> 7) + (n0 & 127) + (which == 1 ? 128 : 0), scr, F.lane); }
        else { const int kb = q / (D / 32), nb = q % (D / 32);
            transpose_item(A.in[I_EWD] + (size_t)e * DE * D, D, 64 * kb, 32 * nb, WDt, DE, e * D + 32 * nb, scr, F.lane); }
    }
}
__device__ __forceinline__ void load_offsets(const Frame& F, const Args& A) {
    LAS int* offs = (LAS int*)(F.lds + OFFS_OFF);
    if (F.tid == 0) { int o = 0;
        for (int e = 0; e < NE; ++e) { offs[e] = o; const int c = (int)__hip_atomic_load(F.ctl + CW_CNT + 64 * e, __ATOMIC_RELAXED, __HIP_MEMORY_SCOPE_AGENT); o += (c + 255) & ~255; }
        offs[NE] = o; }
    __syncthreads();
}
__device__ __forceinline__ void p6a_gather(const Frame& F, const Args& A) {
    load_offsets(F, A);
    const LAS int* offs = (const LAS int*)(F.lds + OFFS_OFF);
    const int gw = blockIdx.x * NWAVES + F.wave, NGW = F.G * NWAVES;
    const float* H1 = A.out; bf16* XS = (bf16*)(A.ws + WS_XS);
    const int* tok_e = (const int*)(A.ws + WS_TOK); const int* tok_r0 = tok_e + M; const int* tok_r1 = tok_e + 2 * M; const float* tok_rs = (const float*)(tok_e + 5 * M);
    int* tok_s0 = (int*)(A.ws + WS_TOK) + 6 * M; int* tok_s1 = tok_s0 + M;
    const f32x4* gf4 = (const f32x4*)A.in[I_GFFN] + F.lane;
    for (int m = gw; m < M; m += NGW) {
        const int ee = tok_e[m], e0 = ee & 255, e1 = (ee >> 8) & 255;
        const int s0 = offs[e0] + tok_r0[m], s1 = offs[e1] + tok_r1[m];
        const float rs = tok_rs[m];
        const f32x4* hr = (const f32x4*)(H1 + (size_t)m * D) + F.lane;
        v2u* o0 = (v2u*)(XS + (size_t)s0 * D) + F.lane; v2u* o1 = (v2u*)(XS + (size_t)s1 * D) + F.lane;
#pragma unroll
        for (int j = 0; j < 4; ++j) { const f32x4 v = hr[64 * j] * rs * gf4[64 * j]; v2u o; o.x = pk2(v.x, v.y); o.y = pk2(v.z, v.w); o0[64 * j] = o; o1[64 * j] = o; }
        if (F.lane == 0) { tok_s0[m] = s0; tok_s1[m] = s1; }
    }
}
__device__ __forceinline__ void p7_final(const Frame& F, const Args& A) {
    const int gw = blockIdx.x * NWAVES + F.wave, NGW = F.G * NWAVES;
    const bf16* SO = (const bf16*)(A.ws + WS_SOUT);
    const int* tok_e = (const int*)(A.ws + WS_TOK); const float* tok_g0 = (const float*)(tok_e + 3 * M); const float* tok_g1 = (const float*)(tok_e + 4 * M);
    const int* tok_s0 = tok_e + 6 * M; const int* tok_s1 = tok_s0 + M;
    const f32x4* gf4 = (const f32x4*)A.in[I_GFIN] + F.lane;
    for (int m = gw; m < M; m += NGW) {
        const int s0 = tok_s0[m], s1 = tok_s1[m]; const float g0 = tok_g0[m], g1 = tok_g1[m];
        f32x4* hr = (f32x4*)(A.out + (size_t)m * D) + F.lane;
        const v2u* a0 = (const v2u*)(SO + (size_t)s0 * D) + F.lane; const v2u* a1 = (const v2u*)(SO + (size_t)s1 * D) + F.lane;
        f32x4 v[4]; float s = 0.f;
#pragma unroll
        for (int j = 0; j < 4; ++j) { const v2u x0 = a0[64 * j], x1 = a1[64 * j]; f32x4 h = hr[64 * j];
            h.x += g0 * bf2f((unsigned short)(x0.x & 0xffffu)) + g1 * bf2f((unsigned short)(x1.x & 0xffffu)); h.y += g0 * bf2f((unsigned short)(x0.x >> 16)) + g1 * bf2f((unsigned short)(x1.x >> 16));
            h.z += g0 * bf2f((unsigned short)(x0.y & 0xffffu)) + g1 * bf2f((unsigned short)(x1.y & 0xffffu)); h.w += g0 * bf2f((unsigned short)(x0.y >> 16)) + g1 * bf2f((unsigned short)(x1.y >> 16));
            v[j] = h; s += (h.x * h.x + h.y * h.y) + (h.z * h.z + h.w * h.w); }
        const float rs = rsqrtf(wave_sum(s) * (1.f / D) + RMS_EPS);
#pragma unroll
        for (int j = 0; j < 4; ++j) hr[64 * j] = v[j] * rs * gf4[64 * j];
    }
}

__global__ void __launch_bounds__(NTHREADS, 2) fwd_kernel(Args args) {
    extern __shared__ __attribute__((aligned(16))) unsigned char lds_raw[];
    Frame F;
    F.lds = (LAS unsigned char*)lds_raw;
    F.tid = threadIdx.x; F.lane = F.tid & 63; F.wave = __builtin_amdgcn_readfirstlane(F.tid >> 6); F.G = gridDim.x;
    F.ctl = (unsigned*)(args.ws + WS_CTL);
    const Args& A = args;
    volatile LAS unsigned* MISC = (volatile LAS unsigned*)(F.lds + MISC_OFF);
    for (int u = F.tid; u < (LDS_BYTES - RING_BYTES) / 4; u += NTHREADS) ((LAS unsigned*)(F.lds + RING_BYTES))[u] = 0u;
    __syncthreads();
    const int lo = args.ph_lo, hi = args.ph_hi;
    XcdBarrier bar; bar.bar = F.ctl + CW_BAR; bar.x = 0; bar.st = nullptr;
    if (hi - lo > 1) bar = xcd_barrier_post(F.ctl + CW_BAR, MISC + 8);
#define IN(k) (lo <= (k) && (k) < hi)
#ifndef PH_MASK
#define PH_MASK 0x3ff
#endif
#define PH_EN(k) (((PH_MASK) >> (k)) & 1)
#define SEAM(k) do { if (IN(k) && IN((k) + 1)) xcd_barrier(bar); } while (0)
    if (PH_EN(0) && IN(0)) { p0_prologue(F, A); } SEAM(0);
    if (PH_EN(1) && IN(1)) {
        pg8::Gemm g{(const pg8::bf16_t*)(A.ws + WS_XN), (const pg8::bf16_t*)(A.ws + WS_WIN), M, DIN, D}; pg8::StaticOrder S; S.init(M, DIN, F.G, (int)blockIdx.x);
        pg8::EpiBf16<0> E{(pg8::bf16_t*)(A.ws + WS_Z), DIN, nullptr, 0, 0, 1.f};
        pg8::gemm_phase<pg8::EpiBf16<0>, pg8::StaticOrder, true, true>(F.lds, g, S, E);
    } SEAM(1);
    if (PH_EN(2) && IN(2)) { p2_mixprep(F, A); } SEAM(2);
    if (PH_EN(3) && IN(3)) { p3_rwkv(F, A); } SEAM(3);
    if (PH_EN(4) && IN(4)) {
        pg8::Gemm g{(const pg8::bf16_t*)(A.ws + WS_Y), (const pg8::bf16_t*)(A.ws + WS_WOUT), M, D, D}; pg8::StaticOrder S; S.init(M, D, F.G, (int)blockIdx.x);
        pg8::EpiResF32 E{A.in[I_X], A.out, D};
        pg8::gemm_phase<pg8::EpiResF32, pg8::StaticOrder, true, true>(F.lds, g, S, E);
    } SEAM(4);
    if (PH_EN(5) && IN(5)) { p5_router(F, A); } SEAM(5);
    if (PH_EN(6) && IN(6)) { p6a_gather(F, A); } SEAM(6);
    if (PH_EN(7) && IN(7)) {
        load_offsets(F, A);
        pg8::Gemm g{(const pg8::bf16_t*)(A.ws + WS_XS), (const pg8::bf16_t*)(A.ws + WS_WGU), MAXSLOTS, 512, D};
        pg8::MoeOrder S; S.init((const LAS int*)(F.lds + OFFS_OFF), 2, F.G, (int)blockIdx.x, (size_t)512 * D * 2);
        pg8::EpiSwiGLU E{(pg8::bf16_t*)(A.ws + WS_HID), DE};
        pg8::gemm_phase<pg8::EpiSwiGLU, pg8::MoeOrder, true, true>(F.lds, g, S, E);
    } SEAM(7);
    if (PH_EN(8) && IN(8)) {
        load_offsets(F, A);
        pg8::Gemm g{(const pg8::bf16_t*)(A.ws + WS_HID), (const pg8::bf16_t*)(A.ws + WS_WD), MAXSLOTS, D, DE};
        pg8::MoeOrder S; S.init((const LAS int*)(F.lds + OFFS_OFF), 4, F.G, (int)blockIdx.x, (size_t)D * DE * 2);
        pg8::EpiBf16<0> E{(pg8::bf16_t*)(A.ws + WS_SOUT), D, nullptr, 0, 0, 1.f};
        pg8::gemm_phase<pg8::EpiBf16<0>, pg8::MoeOrder, true, true>(F.lds, g, S, E);
    } SEAM(8);
    if (PH_EN(9) && IN(9)) { p7_final(F, A); }
#undef IN
#undef SEAM
}

extern "C" void kernel_launch(void* const* d_in, const int* in_sizes, int n_in, void* d_out, int out_size, void* d_ws, size_t ws_size, hipStream_t stream) {
    static int grid = 0;
    if (grid == 0) {
        if (n_in != 25 || in_sizes[0] != M * D || out_size != M * D || ws_size < WS_END) { fprintf(stderr, "kernel_launch: unexpected shapes (n_in %d, in0 %d, out %d, ws %zu)\n", n_in, n_in > 0 ? in_sizes[0] : -1, out_size, ws_size); grid = -1; return; }
        int dev = 0, cus = 0, per_cu = 0;
        if (hipGetDevice(&dev) != hipSuccess || hipDeviceGetAttribute(&cus, hipDeviceAttributeMultiprocessorCount, dev) != hipSuccess) { grid = -1; return; }
        if (hipFuncSetAttribute((const void*)fwd_kernel, hipFuncAttributeMaxDynamicSharedMemorySize, LDS_BYTES) != hipSuccess) { fprintf(stderr, "kernel_launch: hipFuncSetAttribute failed\n"); grid = -1; return; }
        if (hipOccupancyMaxActiveBlocksPerMultiprocessor(&per_cu, (const void*)fwd_kernel, NTHREADS, LDS_BYTES) != hipSuccess || per_cu < 1) { fprintf(stderr, "kernel_launch: occupancy query says %d blocks per CU\n", per_cu); per_cu = 1; }
        (void)hipGetLastError();
        grid = cus;
    }
    if (grid < 0) return;
    (void)hipMemsetAsync((char*)d_ws + WS_CTL, 0, CTL_ZERO_BYTES, stream);
    Args a{};
    for (int i = 0; i < 25; ++i) a.in[i] = (const float*)d_in[i];
    a.out = (float*)d_out; a.ws = (unsigned char*)d_ws;
#if MK_N_LAUNCHES == 1
    a.ph_lo = 0; a.ph_hi = NPHASES;
    void* kargs[] = {&a};
    hipError_t e = hipLaunchCooperativeKernel((const void*)fwd_kernel, dim3(grid), dim3(NTHREADS), kargs, LDS_BYTES, stream);
    if (e != hipSuccess) fprintf(stderr, "kernel_launch: cooperative launch failed: %s (grid %d)\n", hipGetErrorString(e), grid);
#else
    for (int p = 0; p < NPHASES; ++p) { a.ph_lo = p; a.ph_hi = p + 1; hipLaunchKernelGGL(fwd_kernel, dim3(grid), dim3(NTHREADS), LDS_BYTES, stream, a); }
#endif
}
```

```cpp
#include <hip/hip_runtime.h>
#include <cstdio>
#include <cstdint>
namespace pg8 {
#define PG8_LAS __attribute__((address_space(3)))
typedef unsigned short bf16_t;
typedef short bf16x8 __attribute__((ext_vector_type(8)));
typedef float f32x4 __attribute__((ext_vector_type(4)));
typedef unsigned u32x4 __attribute__((ext_vector_type(4)));
constexpr int BM = 256, BK = 64, HALF = 128, HTB = HALF * BK * 2  , STAGE_BYTES = 8 * HTB, NXCD = 8, WGM = 8;

__host__ __device__ __forceinline__ int lds_byte(int r, int c) { const int st = (r >> 4) * 2 + (c >> 5), rr = r & 15, cc = c & 31, ob = rr * 64 + cc * 2; return st * 1024 + (ob ^ (((ob >> 9) & 1) << 5)); }
__host__ __device__ __forceinline__ void stage_rc(int b, int& R, int& C) { const int st = b / 1024, sb = b % 1024, swz = sb ^ (((sb >> 9) & 1) << 5); R = (st >> 1) * 16 + swz / 64; C = (st & 1) * 32 + (swz % 64) / 2; }
__host__ __device__ __forceinline__ int perm32(int rho) { const int n = rho >> 4, i = rho & 15; return 8 * (i >> 2) + 4 * n + (i & 3); }


struct Unit { int pm, pn, e; };
struct Gemm { const bf16_t* A; const bf16_t* Bt; int M, N, K; };

struct StaticOrder {
    int nM, nN, nwg, G, c;
    __host__ __device__ void init(int M, int N, int G_, int c_) { nM = M / BM; nN = N / BM; nwg = nM * nN; G = G_; c = c_; }
    __host__ __device__ bool next(int i, Unit& u) const {
        const long L = (long)i * G + c; if (L >= nwg) return false;
        int wgid = (int)L; { const int q = nwg / NXCD, r = nwg % NXCD, xcd = wgid % NXCD, off = wgid / NXCD; wgid = (xcd < r ? xcd * (q + 1) : r * (q + 1) + (xcd - r) * q) + off; }
        const int nig = WGM * nN, gid = wgid / nig, fm = gid * WGM, gsz = (nM - fm) < WGM ? (nM - fm) : WGM;
        u.pm = fm + ((wgid % nig) % gsz); u.pn = (wgid % nig) / gsz; u.e = 0; return true;
    }
    __device__ __forceinline__ const char* a_ptr(const Gemm& g, const Unit& u, size_t tstep) const { return (const char*)g.A + (size_t)u.pm * tstep; }
    __device__ __forceinline__ const char* b_ptr(const Gemm& g, const Unit& u, size_t tstep) const { return (const char*)g.Bt + (size_t)u.pn * tstep; }
    __device__ __forceinline__ void a_ready(const Unit&) const {}
    __device__ __forceinline__ void done(const Unit&) const {}
};
struct MoeOrder {
    const PG8_LAS int* off; int nct, nunits, G, c; size_t estride;
    __device__ __forceinline__ void init(const PG8_LAS int* off_, int nct_, int G_, int c_, size_t estride_) {
        off = off_; nct = nct_; G = G_; c = c_; estride = estride_; nunits = __builtin_amdgcn_readfirstlane((off_[32] >> 8) * nct_); }
    __device__ __forceinline__ bool next(int i, Unit& u) const {
        const int L = i * G + c; if (L >= nunits) return false;
        const int rt = L / nct, ct = L - rt * nct, pos = rt << 8; int e = 0;
#pragma unroll
        for (int j = 1; j < 32; ++j) e += (off[j] <= pos) ? 1 : 0;
        u.pm = rt; u.pn = ct; u.e = __builtin_amdgcn_readfirstlane(e); return true;
    }
    __device__ __forceinline__ const char* a_ptr(const Gemm& g, const Unit& u, size_t tstep) const { return (const char*)g.A + (size_t)u.pm * tstep; }
    __device__ __forceinline__ const char* b_ptr(const Gemm& g, const Unit& u, size_t tstep) const { return (const char*)g.Bt + (size_t)u.e * estride + (size_t)u.pn * tstep; }
    __device__ __forceinline__ void a_ready(const Unit&) const {}
    __device__ __forceinline__ void done(const Unit&) const {}
};

__device__ __forceinline__ unsigned cvt_pk_bf16(float lo, float hi) { unsigned r; asm volatile("v_cvt_pk_bf16_f32 %0, %1, %2" : "=v"(r) : "v"(lo), "v"(hi)); return r; }
template <int ACT  > struct EpiBf16 {
    static constexpr bool PERM = true, AFTER_DRAIN = false; static_assert(ACT == 0, "EpiBf16: ACT is 0 (none)");
    bf16_t* O; int ldc; const float* bias; int split_cols; size_t split_stride; float scale0;
    __device__ __forceinline__ void operator()(const f32x4 (&acc)[2][2][4][2], const Unit& u, int wr, int wc, int fr, int fq) const {
        const int row0 = u.pm * BM + wr * 64 + fr; int colt = u.pn * BM; bf16_t* base = O;
        float sc = 1.f; if (split_cols) { const int t = colt / split_cols; base += (size_t)t * split_stride; colt -= t * split_cols; if (t == 0) sc = scale0; }
        const int col0 = colt + wc * 32 + 8 * fq, bcol0 = u.pn * BM + wc * 32 + 8 * fq;
        f32x4 bv[2][2];
#pragma unroll
        for (int bj = 0; bj < 2; ++bj)
#pragma unroll
            for (int n = 0; n < 2; ++n) bv[bj][n] = bias ? *(const f32x4*)(bias + bcol0 + bj * HALF + 4 * n) : (f32x4){0.f, 0.f, 0.f, 0.f};
#pragma unroll
        for (int ai = 0; ai < 2; ++ai)
#pragma unroll
            for (int m = 0; m < 4; ++m) { bf16_t* rowp = base + (size_t)(row0 + ai * HALF + m * 16) * ldc + col0;
#pragma unroll
                for (int bj = 0; bj < 2; ++bj) { f32x4 v0 = acc[ai][bj][m][0] + bv[bj][0], v1 = acc[ai][bj][m][1] + bv[bj][1];
                    v0 = v0 * sc; v1 = v1 * sc; u32x4 w; w.x = cvt_pk_bf16(v0[0], v0[1]); w.y = cvt_pk_bf16(v0[2], v0[3]); w.z = cvt_pk_bf16(v1[0], v1[1]); w.w = cvt_pk_bf16(v1[2], v1[3]);
                    *(u32x4*)(rowp + bj * HALF) = w; } }
    }
};
struct EpiResF32 {
    static constexpr bool PERM = false, AFTER_DRAIN = false;
    const float* base; float* C; int ldc;
    __device__ __forceinline__ void operator()(const f32x4 (&acc)[2][2][4][2], const Unit& u, int wr, int wc, int fr, int fq) const {
        const int row0 = u.pm * BM + wr * 64 + fr, col0 = u.pn * BM + wc * 32 + 4 * fq;
#pragma unroll
        for (int ai = 0; ai < 2; ++ai)
#pragma unroll
            for (int m = 0; m < 4; ++m) { const size_t o = (size_t)(row0 + ai * HALF + m * 16) * ldc + col0;
#pragma unroll
                for (int bj = 0; bj < 2; ++bj)
#pragma unroll
                    for (int n = 0; n < 2; ++n) *(f32x4*)(C + o + bj * HALF + n * 16) = acc[ai][bj][m][n] + *(const f32x4*)(base + o + bj * HALF + n * 16); }
    }
};
__device__ __forceinline__ float silu_f(float x) { return x * __builtin_amdgcn_rcpf(1.0f + __builtin_amdgcn_exp2f(-1.4426950408889634f * x)); }
struct EpiSwiGLU {
    static constexpr bool PERM = true, AFTER_DRAIN = false;
    bf16_t* H; int ldc;
    __device__ __forceinline__ void operator()(const f32x4 (&acc)[2][2][4][2], const Unit& u, int wr, int wc, int fr, int fq) const {
        const int row0 = u.pm * BM + wr * 64 + fr, col0 = u.pn * HALF + wc * 32 + 8 * fq;
#pragma unroll
        for (int ai = 0; ai < 2; ++ai)
#pragma unroll
            for (int m = 0; m < 4; ++m) { bf16_t* rowp = H + (size_t)(row0 + ai * HALF + m * 16) * ldc + col0;
                const f32x4 g0 = acc[ai][0][m][0], g1 = acc[ai][0][m][1], u0 = acc[ai][1][m][0], u1 = acc[ai][1][m][1];
                u32x4 w; w.x = cvt_pk_bf16(silu_f(g0[0]) * u0[0], silu_f(g0[1]) * u0[1]); w.y = cvt_pk_bf16(silu_f(g0[2]) * u0[2], silu_f(g0[3]) * u0[3]);
                w.z = cvt_pk_bf16(silu_f(g1[0]) * u1[0], silu_f(g1[1]) * u1[1]); w.w = cvt_pk_bf16(silu_f(g1[2]) * u1[2], silu_f(g1[3]) * u1[3]);
                *(u32x4*)rowp = w; }
    }
};

struct EpiLora {
    static constexpr bool PERM = false, AFTER_DRAIN = false;
    float* O0; const float* base0; const float* base1; size_t d1, d2;
    __device__ __forceinline__ void operator()(const f32x4 (&acc)[2][2][4][2], const Unit& u, int wr, int wc, int fr, int fq) const {
        const int which = u.pn >> 1, row0 = u.pm * BM + wr * 64 + fr, col0 = (u.pn & 1) * BM + wc * 32 + 4 * fq;
        float* O = O0 + (which == 0 ? (size_t)0 : (which == 1 ? d1 : d2)) + (size_t)row0 * 512 + col0; const float* bs = (which == 0 ? base0 : base1) + col0;
        const float esc = (which == 0) ? -0.8750352804f : 0.f;
#pragma unroll
        for (int bj = 0; bj < 2; ++bj)
#pragma unroll
            for (int n = 0; n < 2; ++n) {
                f32x4 bv = (f32x4){0.f, 0.f, 0.f, 0.f};
                if (which < 2) bv = *(const f32x4*)(bs + bj * HALF + n * 16);
#pragma unroll
                for (int ai = 0; ai < 2; ++ai)
#pragma unroll
                    for (int m = 0; m < 4; ++m) { f32x4 v = acc[ai][bj][m][n] + bv;
                        if (which < 2) {
#pragma unroll
                            for (int i = 0; i < 4; ++i) { const float sg = __builtin_amdgcn_rcpf(1.0f + __builtin_amdgcn_exp2f(-1.4426950408889634f * v[i])); v[i] = (which == 0) ? __builtin_amdgcn_exp2f(esc * sg) : sg; } }
                        *(f32x4*)(O + (size_t)(ai * HALF + m * 16) * 512 + bj * HALF + n * 16) = v; } }
    }
};

template <class Epi, class Sched, bool ALIGN_EPI = false, bool SP2 = false>
__device__ __forceinline__ void gemm_phase(PG8_LAS unsigned char* lds, const Gemm g, const Sched& S, const Epi& E) {
    const int tid = threadIdx.x, wid = __builtin_amdgcn_readfirstlane(tid >> 6), lane = tid & 63, wr = wid >> 2, wc = wid & 3, fr = lane & 15, fq = lane >> 4;
    const int K = g.K, nt = K / BK;
    unsigned voffA[2], voffB[2];
#pragma unroll
    for (int i = 0; i < 2; ++i) { int R, C; stage_rc(tid * 16 + i * 8192, R, C); const int Rb = Epi::PERM ? ((R & ~31) + perm32(R & 31)) : R;
        voffA[i] = (unsigned)(R * K + C) * 2u; voffB[i] = (unsigned)(Rb * K + C) * 2u; }
    const size_t kstep = (size_t)(BK * 2);
    const size_t hstep = (size_t)HALF * K * 2;
    const size_t tstep = 2 * hstep;
    const unsigned ldsw = (unsigned)wid * 1024u;
    const int aoff = lds_byte(wr * 64 + fr, fq * 8), boff = lds_byte(wc * 32 + fr, fq * 8);
#define PG8_SA(b, h) (((b) * 2 + (h)) * HTB)
#define PG8_SB(b, h) ((4 + (b) * 2 + (h)) * HTB)
#define PG8_STAGE(bufoff, gbase, voff) do { _Pragma("unroll") for (int _i = 0; _i < 2; ++_i) \
        __builtin_amdgcn_global_load_lds((const unsigned*)((const char*)(gbase) + (voff)[_i]), (PG8_LAS unsigned*)(lds + (bufoff) + ldsw + _i * 8192), 16, 0, 0); } while (0)
#define PG8_LDA(dst, b, h) do { _Pragma("unroll") for (int m = 0; m < 4; ++m) _Pragma("unroll") for (int k = 0; k < 2; ++k) dst[m][k] = *(const PG8_LAS bf16x8*)(lds + PG8_SA(b, h) + aoff + m * 2048 + k * 1024); } while (0)
#define PG8_LDB(dst, b, h) do { _Pragma("unroll") for (int n = 0; n < 2; ++n) _Pragma("unroll") for (int k = 0; k < 2; ++k) dst[n][k] = *(const PG8_LAS bf16x8*)(lds + PG8_SB(b, h) + boff + n * 2048 + k * 1024); } while (0)
#define PG8_MMA(ai, bj, At, Bt) do { __builtin_amdgcn_s_setprio(1); _Pragma("unroll") for (int m = 0; m < 4; ++m) _Pragma("unroll") for (int n = 0; n < 2; ++n) _Pragma("unroll") for (int k = 0; k < 2; ++k) \
        acc[ai][bj][m][n] = __builtin_amdgcn_mfma_f32_16x16x32_bf16(Bt[n][k], At[m][k], acc[ai][bj][m][n], 0, 0, 0); __builtin_amdgcn_s_setprio(0); } while (0)
#define PG8_WAIT_V(n) asm volatile("s_waitcnt vmcnt(" #n ")" ::: "memory")
#define PG8_WAIT_L(n) asm volatile("s_waitcnt lgkmcnt(" #n ")" ::: "memory")
#define PG8_BAR __builtin_amdgcn_s_barrier()
#define PG8_SCHED __builtin_amdgcn_sched_barrier(0)
    Unit cur, nxt; int ui = 0;
    if (!S.next(0, cur)) return;
    f32x4 acc[2][2][4][2];
#pragma unroll
    for (int a = 0; a < 2; ++a)
#pragma unroll
        for (int b = 0; b < 2; ++b)
#pragma unroll
            for (int m = 0; m < 4; ++m)
#pragma unroll
                for (int n = 0; n < 2; ++n) acc[a][b][m][n] = (f32x4){0.f, 0.f, 0.f, 0.f};
    bf16x8 At[4][2], B0[2][2], B1[2][2];
    const char* cA = S.a_ptr(g, cur, tstep); const char* cB = S.b_ptr(g, cur, tstep);
    S.a_ready(cur);
    if constexpr (SP2) {
        PG8_STAGE(PG8_SB(0, 0), cB, voffB); PG8_STAGE(PG8_SB(0, 1), cB + hstep, voffB); PG8_STAGE(PG8_SA(0, 0), cA, voffA); PG8_STAGE(PG8_SA(0, 1), cA + hstep, voffA);
        if (wr == 1) PG8_BAR;
        PG8_WAIT_V(2); PG8_BAR;
        PG8_STAGE(PG8_SB(1, 0), cB + kstep, voffB); PG8_STAGE(PG8_SA(1, 0), cA + kstep, voffA); PG8_STAGE(PG8_SB(1, 1), cB + hstep + kstep, voffB);
        PG8_WAIT_V(6); PG8_BAR;
    } else {
        PG8_STAGE(PG8_SB(0, 0), cB, voffB); PG8_STAGE(PG8_SA(0, 0), cA, voffA); PG8_STAGE(PG8_SB(0, 1), cB + hstep, voffB); PG8_STAGE(PG8_SA(0, 1), cA + hstep, voffA);
        if (wr == 1) PG8_BAR;
        PG8_WAIT_V(4); PG8_BAR;
        PG8_STAGE(PG8_SB(1, 0), cB + kstep, voffB); PG8_STAGE(PG8_SA(1, 0), cA + kstep, voffA); PG8_STAGE(PG8_SB(1, 1), cB + hstep + kstep, voffB);
        PG8_WAIT_V(6); PG8_BAR;
    }
    for (;;) {
        const bool has_next = S.next(ui + 1, nxt);
        const char* nA = has_next ? S.a_ptr(g, nxt, tstep) : cA; const char* nB = has_next ? S.b_ptr(g, nxt, tstep) : cB;
        for (int t = 0; t < nt; t += 2) {
            const bool last = (t == nt - 2);
            const char* a1 = cA + (size_t)(t + 1) * kstep;
            const char* a2 = last ? nA : cA + (size_t)(t + 2) * kstep; const char* b2 = last ? nB : cB + (size_t)(t + 2) * kstep;
            const char* a3 = a2 + kstep; const char* b3 = b2 + kstep;
            if (last && has_next) S.a_ready(nxt);
            if constexpr (SP2) {
            PG8_LDB(B0, 0, 0); PG8_LDB(B1, 0, 1); PG8_SCHED; PG8_LDA(At, 0, 0); PG8_STAGE(PG8_SA(1, 1), a1 + hstep, voffA);
            PG8_WAIT_V(8); PG8_WAIT_L(0); PG8_BAR; PG8_MMA(0, 0, At, B0); PG8_MMA(0, 1, At, B1); PG8_BAR; PG8_SCHED;
            PG8_LDA(At, 0, 1); PG8_STAGE(PG8_SB(0, 0), b2, voffB); PG8_STAGE(PG8_SB(0, 1), b2 + hstep, voffB); PG8_STAGE(PG8_SA(0, 0), a2, voffA);
            PG8_WAIT_V(8); PG8_WAIT_L(0); PG8_BAR; PG8_MMA(1, 0, At, B0); PG8_MMA(1, 1, At, B1); PG8_BAR; PG8_SCHED;
            PG8_LDB(B0, 1, 0); PG8_LDB(B1, 1, 1); PG8_SCHED; PG8_LDA(At, 1, 0); PG8_STAGE(PG8_SA(0, 1), a2 + hstep, voffA);
            PG8_WAIT_V(8); PG8_WAIT_L(0); PG8_BAR; PG8_MMA(0, 0, At, B0); PG8_MMA(0, 1, At, B1); PG8_BAR; PG8_SCHED;
            PG8_LDA(At, 1, 1); PG8_STAGE(PG8_SB(1, 0), b3, voffB); PG8_STAGE(PG8_SB(1, 1), b3 + hstep, voffB); PG8_STAGE(PG8_SA(1, 0), a3, voffA);
            PG8_WAIT_V(8); PG8_WAIT_L(0); PG8_BAR; PG8_MMA(1, 0, At, B0); PG8_MMA(1, 1, At, B1); PG8_BAR; PG8_SCHED;
            } else {
            PG8_LDB(B0, 0, 0); PG8_SCHED; PG8_LDA(At, 0, 0); PG8_STAGE(PG8_SA(1, 1), a1 + hstep, voffA);
            PG8_WAIT_L(8); PG8_BAR; PG8_WAIT_L(0); PG8_MMA(0, 0, At, B0); PG8_BAR; PG8_SCHED;
            PG8_LDB(B1, 0, 1); PG8_STAGE(PG8_SB(0, 0), b2, voffB);
            PG8_BAR; PG8_WAIT_L(0); PG8_MMA(0, 1, At, B1); PG8_BAR;
            PG8_LDA(At, 0, 1); PG8_STAGE(PG8_SA(0, 0), a2, voffA);
            PG8_BAR; PG8_WAIT_L(0); PG8_MMA(1, 0, At, B0); PG8_BAR; PG8_SCHED;
            PG8_STAGE(PG8_SB(0, 1), b2 + hstep, voffB);
            PG8_WAIT_V(6); PG8_BAR; PG8_MMA(1, 1, At, B1); PG8_BAR;
            PG8_LDB(B0, 1, 0); PG8_SCHED; PG8_LDA(At, 1, 0); PG8_STAGE(PG8_SA(0, 1), a2 + hstep, voffA);
            PG8_WAIT_L(8); PG8_BAR; PG8_WAIT_L(0); PG8_MMA(0, 0, At, B0); PG8_BAR; PG8_SCHED;
            PG8_LDB(B1, 1, 1); PG8_STAGE(PG8_SB(1, 0), b3, voffB);
            PG8_BAR; PG8_WAIT_L(0); PG8_MMA(0, 1, At, B1); PG8_BAR;
            PG8_LDA(At, 1, 1); PG8_STAGE(PG8_SA(1, 0), a3, voffA);
            PG8_BAR; PG8_WAIT_L(0); PG8_MMA(1, 0, At, B0); PG8_BAR; PG8_SCHED;
            PG8_STAGE(PG8_SB(1, 1), b3 + hstep, voffB);
            PG8_WAIT_V(6); PG8_BAR; PG8_MMA(1, 1, At, B1); PG8_BAR;
            }
        }
        if constexpr (ALIGN_EPI) { if (wr == 0) PG8_BAR; }
        if constexpr (!Epi::AFTER_DRAIN) { E(acc, cur, wr, wc, fr, fq); S.done(cur); }
        if (!has_next) break;
#pragma unroll
        for (int a = 0; a < 2; ++a)
#pragma unroll
            for (int b = 0; b < 2; ++b)
#pragma unroll
                for (int m = 0; m < 4; ++m)
#pragma unroll
                    for (int n = 0; n < 2; ++n) acc[a][b][m][n] = (f32x4){0.f, 0.f, 0.f, 0.f};
        cur = nxt; cA = nA; cB = nB; ++ui;
        if constexpr (ALIGN_EPI) { if (wr == 1) PG8_BAR; }
    }
    PG8_WAIT_V(0);
    if constexpr (!ALIGN_EPI) { if (wr == 0) PG8_BAR; }
    PG8_BAR;
    if constexpr (Epi::AFTER_DRAIN) { E.fused(acc, cur, wr, wc, fr, fq, lds, wid, lane); S.done(cur); }
#undef PG8_SA
#undef PG8_SB
#undef PG8_STAGE
#undef PG8_LDA
#undef PG8_LDB
#undef PG8_MMA
#undef PG8_WAIT_V
#undef PG8_WAIT_L
#undef PG8_BAR
#undef PG8_SCHED
}
}
constexpr int NWAVES = 8, NTHREADS = NWAVES * 64;
constexpr int BATCH = 8, SEQ = 2048, D = 1024, M = BATCH * SEQ;
constexpr int DCONV = 512, DRWKV = 512, HEADS = 8, HD = 64;
constexpr int DIN = 3328;
constexpr int ZR = 1536, ZK = 2048, ZV = 2560, ZLO = 3072;
constexpr int NE = 32, NG = 4, EPG = 8, DE = 256;
constexpr int MAXSLOTS = 41216;
constexpr float RMS_EPS = 1e-6f, LN_X_EPS = 64e-5f;
#ifndef MK_N_LAUNCHES
#define MK_N_LAUNCHES 1
#endif
constexpr int NPHASES = 12;
constexpr size_t MiB = 1u << 20;
constexpr size_t WS_CTL = 0, CTL_ZERO_BYTES = 64 * 1024;
constexpr size_t WS_WRT = 1 * MiB;
constexpr size_t WS_TOK = 1 * MiB + 256 * 1024;
constexpr size_t WS_WIN = 2 * MiB, WS_WOUT = 9 * MiB;
constexpr size_t WS_XN = 12 * MiB, WS_AUX0 = 12 * MiB, WS_Z = 44 * MiB, WS_Y = 148 * MiB, WS_AUX1 = 180 * MiB, WS_AUX2 = 212 * MiB;
constexpr size_t WS_WGU = 12 * MiB, WS_WD = 44 * MiB, WS_XS = 60 * MiB, WS_HID = 141 * MiB, WS_SOUT = 162 * MiB, WS_BON = 244 * MiB, WS_LIN = 245 * MiB, WS_W3 = 253 * MiB, WS_END = 254 * MiB;
static_assert(WS_WIN + (size_t)DIN * D * 2 <= WS_WOUT && WS_WOUT + (size_t)D * D * 2 <= WS_XN, "ws map");
static_assert(WS_XS + (size_t)MAXSLOTS * D * 2 <= WS_HID && WS_HID + (size_t)MAXSLOTS * DE * 2 <= WS_SOUT && WS_SOUT + (size_t)MAXSLOTS * D * 2 <= WS_BON, "ws map");
static_assert(WS_Z + (size_t)M * DIN * 2 <= WS_Y, "ws map");
constexpr int CW_TMO = 0, CW_BAR = 1024, CW_CNT = 8192;
constexpr int RING_BYTES = 131072, MISC_OFF = RING_BYTES + 320, OFFS_OFF = MISC_OFF + 128, LDS_BYTES = 147456;

#define GAS __attribute__((address_space(1)))
#define LAS __attribute__((address_space(3)))
typedef unsigned short bf16;
typedef unsigned v4u __attribute__((ext_vector_type(4)));
typedef unsigned v2u __attribute__((ext_vector_type(2)));
typedef float f32x4 __attribute__((ext_vector_type(4)));
typedef unsigned short us4 __attribute__((ext_vector_type(4)));
#define LDS_WAIT() asm volatile("s_waitcnt lgkmcnt(0)" ::: "memory")
__device__ __forceinline__ unsigned f2bf(float f) { unsigned u = __builtin_bit_cast(unsigned, f); return (u + 0x7fffu + ((u >> 16) & 1u)) >> 16; }
__device__ __forceinline__ unsigned pk2(float lo, float hi) { return f2bf(lo) | (f2bf(hi) << 16); }
__device__ __forceinline__ float bf2f(unsigned short b) { return __builtin_bit_cast(float, (unsigned)b << 16); }
__device__ __forceinline__ float sigmoid_f(float x) { return 1.0f / (1.0f + __expf(-x)); }

#define XB_TMO      128
#define XB_XCNT(j)  (256  + 64 * (j))
#define XB_XSUB(j)  (1280 + 64 * (j))
#define XB_XGEN(j)  (2304 + 64 * (j))
#define XB_TOP      3328
#define XB_TOPGEN   3392
#define XCD_BAR_WORDS 3456
#define XB_SPIN_CAP (1u << 18)
__device__ __forceinline__ unsigned xb_ld(unsigned* p)              { return __hip_atomic_load(p, __ATOMIC_RELAXED, __HIP_MEMORY_SCOPE_AGENT); }
__device__ __forceinline__ unsigned xb_add(unsigned* p, unsigned v) { return __hip_atomic_fetch_add(p, v, __ATOMIC_RELAXED, __HIP_MEMORY_SCOPE_AGENT); }
__device__ __forceinline__ unsigned xb_xcc_id() { return (unsigned)__builtin_amdgcn_s_getreg((3 << 11) | 20) & 0xFu; }
#define XB_SPIN(cond, bar) do { unsigned _sp = 0; while (cond) { __builtin_amdgcn_s_sleep(1); \
    if ((++_sp & 255u) == 0u) { if (xb_ld(&(bar)[XB_TMO])) break; if (_sp > XB_SPIN_CAP) { atomicAdd(&(bar)[XB_TMO], 1u); break; } } } } while (0)
struct XcdBarrier { unsigned* bar; unsigned x; volatile LAS unsigned* st; };
__device__ __forceinline__ XcdBarrier xcd_barrier_post(unsigned* bar, volatile LAS unsigned* st) {
    XcdBarrier b; b.bar = bar; b.x = xb_xcc_id(); b.st = st;
    if (threadIdx.x == 0) (void)xb_add(&bar[XB_XCNT(b.x)], 1u);
    return b;
}
__device__ __forceinline__ void xcd_barrier_complete(unsigned* bar, unsigned x, unsigned& nloc, unsigned& nx) {
    const unsigned G = gridDim.x * gridDim.y * gridDim.z;
    unsigned sum, cnt, mine, sp = 0u;
    for (;;) {
        sum = 0u; cnt = 0u; mine = 0u;
#pragma unroll
        for (unsigned j = 0; j < 16; ++j) { const unsigned c = xb_ld(&bar[XB_XCNT(j)]); sum += c; cnt += (c > 0u) ? 1u : 0u; mine = (j == x) ? c : mine; }
        if (sum == G) break;
        __builtin_amdgcn_s_sleep(1);
        if ((++sp & 255u) == 0u) { if (xb_ld(&bar[XB_TMO])) break; if (sp > XB_SPIN_CAP) { atomicAdd(&bar[XB_TMO], 1u); break; } }
    }
    nloc = mine > 0u ? mine : 1u; nx = cnt > 0u ? cnt : 1u;
}
__device__ __forceinline__ void xcd_barrier(const XcdBarrier& b) {
    asm volatile("s_waitcnt vmcnt(0)" ::: "memory");
    __syncthreads();
    if (threadIdx.x == 0) {
        unsigned* bar = b.bar;
        __builtin_amdgcn_s_waitcnt(0);
        unsigned nloc = b.st[0], nx = b.st[1];
        if (nloc == 0u) { xcd_barrier_complete(bar, b.x, nloc, nx); b.st[0] = nloc; b.st[1] = nx; }
        const unsigned old = xb_add(&bar[XB_XSUB(b.x)], 1u);
        const unsigned gen = old / nloc;
        if (old + 1u == (gen + 1u) * nloc) {
            __builtin_amdgcn_fence(__ATOMIC_RELEASE, "agent");
            asm volatile("s_waitcnt vmcnt(0)" ::: "memory");
            const unsigned og = xb_add(&bar[XB_TOP], 1u);
            const unsigned tg = og / nx;
            if (og + 1u == (tg + 1u) * nx) xb_add(&bar[XB_TOPGEN], 1u);
            else XB_SPIN(xb_ld(&bar[XB_TOPGEN]) == tg, bar);
            __builtin_amdgcn_fence(__ATOMIC_ACQUIRE, "agent");
            xb_add(&bar[XB_XGEN(b.x)], 1u);
            asm volatile("s_waitcnt vmcnt(0)" ::: "memory");
        } else {
            XB_SPIN(xb_ld(&bar[XB_XGEN(b.x)]) == gen, bar);
            __builtin_amdgcn_fence(__ATOMIC_ACQUIRE, "agent");
            asm volatile("s_waitcnt vmcnt(0)" ::: "memory");
        }
    }
    __syncthreads();
}

struct Args { const float* in[25]; float* out; unsigned char* ws; int ph_lo, ph_hi; };
struct Frame {
    LAS unsigned char* lds;
    int tid, lane, wave, G;
    unsigned* ctl;
};
enum InIdx { I_X = 0, I_G1, I_WIN, I_MU, I_CONVW, I_DECUP, I_DECBASE, I_AUP, I_ABASE, I_GUP, I_KK, I_KA, I_RK, I_LNW, I_LNB, I_WOUT, I_GFFN, I_RGW, I_RGB, I_REW, I_REB, I_EWG, I_EWU, I_EWD, I_GFIN };

__device__ __forceinline__ float wave_sum(float v) {
#pragma unroll
    for (int o = 1; o < 64; o <<= 1) v += __shfl_xor(v, o);
    return v;
}
__device__ __forceinline__ float sum16(float v) { v += __shfl_xor(v, 1); v += __shfl_xor(v, 2); v += __shfl_xor(v, 4); v += __shfl_xor(v, 8); return v; }
__device__ __forceinline__ float sum8(float v) { v += __shfl_xor(v, 1); v += __shfl_xor(v, 2); v += __shfl_xor(v, 4); return v; }

__device__ __forceinline__ void transpose_item(const float* W, int N, int k0, int n0, bf16* WT, int ldk, int drow0, LAS float* scr, int lane) {
#pragma unroll 8
    for (int i = 0; i < 32; ++i) { const int kk = 2 * i + (lane >> 5); scr[kk * 33 + (lane & 31)] = W[(size_t)(k0 + kk) * N + n0 + (lane & 31)]; }
    LDS_WAIT(); asm volatile("" ::: "memory");
    const int c = lane & 7;
#pragma unroll
    for (int j = 0; j < 4; ++j) { const int n = (lane >> 3) + 8 * j; const LAS float* s = scr + (8 * c) * 33 + n;
        v4u o; o.x = pk2(s[0 * 33], s[1 * 33]); o.y = pk2(s[2 * 33], s[3 * 33]); o.z = pk2(s[4 * 33], s[5 * 33]); o.w = pk2(s[6 * 33], s[7 * 33]);
        *(v4u*)(WT + (size_t)(drow0 + n) * ldk + k0 + 8 * c) = o; }
    LDS_WAIT(); asm volatile("" ::: "memory");
}

__device__ __forceinline__ void p0_prologue(const Frame& F, const Args& A) {
    LAS float* scr = (LAS float*)(F.lds + F.wave * 16384);
    const int gw = blockIdx.x * NWAVES + F.wave, NGW = F.G * NWAVES;
    bf16* WinT = (bf16*)(A.ws + WS_WIN); bf16* WoutT = (bf16*)(A.ws + WS_WOUT);
    constexpr int I_IN = (D / 64) * (DIN / 32), I_OUT = (D / 64) * (D / 32);
    for (int it = gw; it < I_IN + I_OUT; it += NGW) {
        if (it < I_IN) { const int kb = it / (DIN / 32), nb = it % (DIN / 32); transpose_item(A.in[I_WIN], DIN, 64 * kb, 32 * nb, WinT, D, 32 * nb, scr, F.lane); }
        else { const int r = it - I_IN, kb = r / (D / 32), nb = r % (D / 32); transpose_item(A.in[I_WOUT], D, 64 * kb, 32 * nb, WoutT, D, 32 * nb, scr, F.lane); }
    }
    { float* WrT = (float*)(A.ws + WS_WRT);
      for (int i = blockIdx.x * NTHREADS + F.tid; i < 36 * D; i += F.G * NTHREADS) { const int n = i / D, k = i % D;
          WrT[i] = (n < NG) ? A.in[I_RGW][k * NG + n] : A.in[I_REW][k * NE + (n - NG)]; } }
    { bf16* W3T = (bf16*)(A.ws + WS_W3);
      for (int i = blockIdx.x * NTHREADS + F.tid; i < 256 * 1536; i += F.G * NTHREADS) { const int k = i / 1536, n = i % 1536; float v = 0.f;
          if (n < 512) { if (k < 64) v = A.in[I_DECUP][k * 512 + n]; }
          else if (n < 1024) { if (k >= 64 && k < 128) v = A.in[I_AUP][(k - 64) * 512 + (n - 512)]; }
          else { if (k >= 128) v = A.in[I_GUP][(k - 128) * 512 + (n - 1024)]; }
          W3T[(size_t)n * 256 + k] = (bf16)f2bf(v); } }
    bf16* XN = (bf16*)(A.ws + WS_XN);
    const f32x4* g4 = (const f32x4*)A.in[I_G1] + F.lane;
    for (int m = gw; m < M; m += NGW) {
        const f32x4* xr = (const f32x4*)(A.in[I_X] + (size_t)m * D) + F.lane;
        f32x4 v[4]; float s = 0.f;
#pragma unroll
        for (int j = 0; j < 4; ++j) { v[j] = xr[64 * j]; s += (v[j].x * v[j].x + v[j].y * v[j].y) + (v[j].z * v[j].z + v[j].w * v[j].w); }
        const float rs = rsqrtf(wave_sum(s) * (1.f / D) + RMS_EPS);
        v2u* o8 = (v2u*)(XN + (size_t)m * D) + F.lane;
#pragma unroll
        for (int j = 0; j < 4; ++j) { const f32x4 g = g4[64 * j]; v2u o; o.x = pk2(v[j].x * rs * g.x, v[j].y * rs * g.y); o.y = pk2(v[j].z * rs * g.z, v[j].w * rs * g.w); o8[64 * j] = o; }
    }
}

__device__ __forceinline__ float bflo(unsigned w) { return __builtin_bit_cast(float, w << 16); }
__device__ __forceinline__ float bfhi(unsigned w) { return __builtin_bit_cast(float, w & 0xffff0000u); }
__device__ __forceinline__ void p2a_mix(const Frame& F, const Args& A) {
    const bf16* Z = (const bf16*)(A.ws + WS_Z); bf16* Y = (bf16*)(A.ws + WS_Y); bf16* LIN = (bf16*)(A.ws + WS_LIN);
    for (int it = blockIdx.x; it < M / 64; it += F.G) {
        const int m0 = it * 64;
        {
            const int c8 = (F.tid & 63) * 8, r0 = m0 + (F.tid >> 6) * 8, ts = r0 % SEQ;
            float w0[8], w1[8], w2[8];
#pragma unroll
            for (int q = 0; q < 8; ++q) { w0[q] = A.in[I_CONVW][c8 + q]; w1[q] = A.in[I_CONVW][512 + c8 + q]; w2[q] = A.in[I_CONVW][1024 + c8 + q]; }
            float ch2[8], ch1[8];
#pragma unroll
            for (int q = 0; q < 8; ++q) { ch2[q] = 0.f; ch1[q] = 0.f; }
            if (ts != 0) {
                const v4u c2 = *(const v4u*)(Z + (size_t)(r0 - 2) * DIN + 512 + c8), h2 = *(const v4u*)(Z + (size_t)(r0 - 2) * DIN + 1024 + c8);
                const v4u c1 = *(const v4u*)(Z + (size_t)(r0 - 1) * DIN + 512 + c8), h1 = *(const v4u*)(Z + (size_t)(r0 - 1) * DIN + 1024 + c8);
#pragma unroll
                for (int q = 0; q < 4; ++q) { ch2[2 * q] = bflo(c2[q]) * bflo(h2[q]); ch2[2 * q + 1] = bfhi(c2[q]) * bfhi(h2[q]); ch1[2 * q] = bflo(c1[q]) * bflo(h1[q]); ch1[2 * q + 1] = bfhi(c1[q]) * bfhi(h1[q]); }
            }
#pragma unroll
            for (int i = 0; i < 8; ++i) {
                const bf16* zr = Z + (size_t)(r0 + i) * DIN;
                const v4u bg = *(const v4u*)(zr + c8), cg = *(const v4u*)(zr + 512 + c8), hh = *(const v4u*)(zr + 1024 + c8);
                float y[8];
#pragma unroll
                for (int q = 0; q < 4; ++q) {
                    const float ca = bflo(cg[q]) * bflo(hh[q]), cb = bfhi(cg[q]) * bfhi(hh[q]);
                    y[2 * q] = bflo(bg[q]) * (w0[2 * q] * ch2[2 * q] + w1[2 * q] * ch1[2 * q] + w2[2 * q] * ca);
                    y[2 * q + 1] = bfhi(bg[q]) * (w0[2 * q + 1] * ch2[2 * q + 1] + w1[2 * q + 1] * ch1[2 * q + 1] + w2[2 * q + 1] * cb);
                    ch2[2 * q] = ch1[2 * q]; ch1[2 * q] = ca; ch2[2 * q + 1] = ch1[2 * q + 1]; ch1[2 * q + 1] = cb; }
                v4u o; o.x = pk2(y[0], y[1]); o.y = pk2(y[2], y[3]); o.z = pk2(y[4], y[5]); o.w = pk2(y[6], y[7]);
                *(v4u*)(Y + (size_t)(r0 + i) * D + c8) = o;
            }
        }
        {
            const int j8 = (F.tid & 31) * 8; float mu[8];
#pragma unroll
            for (int q = 0; q < 8; ++q) mu[q] = A.in[I_MU][1536 + j8 + q];
#pragma unroll
            for (int i = 0; i < 4; ++i) {
                const int m = m0 + (F.tid >> 5) + 16 * i;
                const v4u zc = *(const v4u*)(Z + (size_t)m * DIN + ZLO + j8); v4u zp = {0u, 0u, 0u, 0u};
                if ((m % SEQ) > 0) zp = *(const v4u*)(Z + (size_t)(m - 1) * DIN + ZLO + j8);
                float f[8];
#pragma unroll
                for (int q = 0; q < 4; ++q) { const float a = bflo(zc[q]), b = bfhi(zc[q]); f[2 * q] = a + (bflo(zp[q]) - a) * mu[2 * q]; f[2 * q + 1] = b + (bfhi(zp[q]) - b) * mu[2 * q + 1]; }
                if (j8 < 64) {
#pragma unroll
                    for (int q = 0; q < 8; ++q) f[q] = tanhf(f[q]); }
                else if (j8 >= 128) {
#pragma unroll
                    for (int q = 0; q < 8; ++q) f[q] = sigmoid_f(f[q]); }
                v4u o; o.x = pk2(f[0], f[1]); o.y = pk2(f[2], f[3]); o.z = pk2(f[4], f[5]); o.w = pk2(f[6], f[7]);
                *(v4u*)(LIN + (size_t)m * 256 + j8) = o;
            }
        }
    }
}
template <int CTRL> __device__ __forceinline__ float dpp_f(float x) { return __builtin_bit_cast(float, __builtin_amdgcn_update_dpp(0, __builtin_bit_cast(int, x), CTRL, 0xF, 0xF, true)); }
__device__ __forceinline__ float dsum8(float v) { v += dpp_f<0xB1>(v); v += dpp_f<0x4E>(v); v += dpp_f<0x141>(v); return v; }
__device__ __forceinline__ float dsum16(float v) { v = dsum8(v); v += dpp_f<0x140>(v); return v; }
constexpr int P3_BUF = 5 * 2048 + 512;
__device__ __forceinline__ void p3_stage(const Args& A, LAS float* buf, int b, int h, int rg, int chunk, int st, const float (&cst)[6][8]) {
    const bf16* Z = (const bf16*)(A.ws + WS_Z);
    const float* A0 = (const float*)(A.ws + WS_AUX0); const float* A1 = (const float*)(A.ws + WS_AUX1);
    const int tl = st >> 3, c8 = (st & 7) * 8, hc = h * HD + c8, t = chunk * 32 + tl, m = b * SEQ + t;
    const bf16* zr = Z + (size_t)m * DIN;
    const v4u rc = *(const v4u*)(zr + ZR + hc), kc = *(const v4u*)(zr + ZK + hc), vc = *(const v4u*)(zr + ZV + hc);
    v4u rp = {0u, 0u, 0u, 0u}, kp = rp, vp = rp;
    if (t > 0) { rp = *(const v4u*)(zr - DIN + ZR + hc); kp = *(const v4u*)(zr - DIN + ZK + hc); vp = *(const v4u*)(zr - DIN + ZV + hc); }
    const f32x4 a_lo = *(const f32x4*)(A1 + (size_t)m * 512 + hc), a_hi = *(const f32x4*)(A1 + (size_t)m * 512 + hc + 4);
    const f32x4 d_lo = *(const f32x4*)(A0 + (size_t)m * 512 + hc), d_hi = *(const f32x4*)(A0 + (size_t)m * 512 + hc + 4);
    float r8[8], kk8[8], kp8[8], v8[8], a8[8]; float ss = 0.f, bd = 0.f;
#pragma unroll
    for (int q = 0; q < 8; ++q) {
        const unsigned rw = rc[q >> 1], kw = kc[q >> 1], vw = vc[q >> 1], rpw = rp[q >> 1], kpw = kp[q >> 1], vpw = vp[q >> 1];
        const float rcq = (q & 1) ? __builtin_bit_cast(float, rw & 0xffff0000u) : __builtin_bit_cast(float, rw << 16);
        const float kcq = (q & 1) ? __builtin_bit_cast(float, kw & 0xffff0000u) : __builtin_bit_cast(float, kw << 16);
        const float vcq = (q & 1) ? __builtin_bit_cast(float, vw & 0xffff0000u) : __builtin_bit_cast(float, vw << 16);
        const float rpq = (q & 1) ? __builtin_bit_cast(float, rpw & 0xffff0000u) : __builtin_bit_cast(float, rpw << 16);
        const float kpq = (q & 1) ? __builtin_bit_cast(float, kpw & 0xffff0000u) : __builtin_bit_cast(float, kpw << 16);
        const float vpq = (q & 1) ? __builtin_bit_cast(float, vpw & 0xffff0000u) : __builtin_bit_cast(float, vpw << 16);
        const float aq = (q < 4) ? a_lo[q & 3] : a_hi[q & 3];
        const float rr = rcq + (rpq - rcq) * cst[0][q], kk = kcq + (kpq - kcq) * cst[1][q], vv = vcq + (vpq - vcq) * cst[2][q];
        r8[q] = rr; v8[q] = vv; a8[q] = aq;
        kk8[q] = kk * cst[3][q]; ss += kk8[q] * kk8[q];
        kp8[q] = kk * (1.0f + (aq - 1.0f) * cst[4][q]); bd += rr * kp8[q] * cst[5][q];
    }
    ss = dsum8(ss); bd = dsum8(bd);
    const float inv = 1.0f / fmaxf(sqrtf(ss), 1e-12f);
    LAS float* p = buf + tl * 64 + c8;
    f32x4 x0, x1;
#pragma unroll
    for (int q = 0; q < 4; ++q) { x0[q] = kk8[q] * inv; x1[q] = kk8[4 + q] * inv; }
    *(LAS f32x4*)(p) = x0; *(LAS f32x4*)(p + 4) = x1;
    *(LAS f32x4*)(p + 2048) = d_lo; *(LAS f32x4*)(p + 2048 + 4) = d_hi;
#pragma unroll
    for (int q = 0; q < 4; ++q) { x0[q] *= a8[q]; x1[q] *= a8[4 + q]; }
    *(LAS f32x4*)(p + 4096) = x0; *(LAS f32x4*)(p + 4096 + 4) = x1;
#pragma unroll
    for (int q = 0; q < 4; ++q) { x0[q] = kp8[q]; x1[q] = kp8[4 + q]; }
    *(LAS f32x4*)(p + 6144) = x0; *(LAS f32x4*)(p + 6144 + 4) = x1;
#pragma unroll
    for (int q = 0; q < 4; ++q) { x0[q] = r8[q]; x1[q] = r8[4 + q]; }
    *(LAS f32x4*)(p + 8192) = x0; *(LAS f32x4*)(p + 8192 + 4) = x1;
    if ((c8 >> 4) == rg) {
#pragma unroll
        for (int q = 0; q < 4; ++q) { x0[q] = v8[q]; x1[q] = v8[4 + q]; }
        LAS float* pv = buf + 10240 + tl * 16 + (c8 & 15);
        *(LAS f32x4*)(pv) = x0; *(LAS f32x4*)(pv + 4) = x1; }
    if (rg == 0 && (st & 7) == 0) ((float*)(A.ws + WS_BON))[(size_t)m * HEADS + h] = bd;
}
__device__ __forceinline__ void p3_rwkv(const Frame& F, const Args& A) {
    LAS float* base = (LAS float*)F.lds;
    float* OB = A.out;
    for (int item = blockIdx.x; item < BATCH * HEADS * 4; item += F.G) {
        const int b = item >> 5, h = (item >> 2) & 7, rg = item & 3;
        const int rl = F.tid >> 4, sub = F.tid & 15;
        f32x4 s = {0.f, 0.f, 0.f, 0.f};
        float cst[6][8];
        { const int hc = h * HD + ((F.tid - 256) & 7) * 8;
#pragma unroll
          for (int q = 0; q < 8; ++q) { cst[0][q] = 0.f; cst[1][q] = 0.f; cst[2][q] = 0.f; cst[3][q] = 0.f; cst[4][q] = 0.f; cst[5][q] = 0.f; }
          if (F.tid >= 256) {
#pragma unroll
            for (int q = 0; q < 8; ++q) { cst[0][q] = A.in[I_MU][hc + q]; cst[1][q] = A.in[I_MU][512 + hc + q]; cst[2][q] = A.in[I_MU][1024 + hc + q]; cst[3][q] = A.in[I_KK][hc + q]; cst[4][q] = A.in[I_KA][hc + q]; cst[5][q] = A.in[I_RK][hc + q]; } } }
        if (F.tid >= 256) p3_stage(A, base, b, h, rg, 0, F.tid - 256, cst);
        __syncthreads();
        for (int chunk = 0; chunk < SEQ / 32; ++chunk) {
            LAS float* buf = base + (chunk & 1) * P3_BUF;
            if (F.tid >= 256) { if (chunk + 1 < SEQ / 32) p3_stage(A, base + ((chunk + 1) & 1) * P3_BUF, b, h, rg, chunk + 1, F.tid - 256, cst); }
            else {
                float* op = OB + (size_t)(b * SEQ + chunk * 32 + sub) * 512 + h * HD + rg * 16 + rl;
                const LAS float* p = buf + sub * 4; const LAS float* pv = buf + 10240 + rl;
                f32x4 kk = *(const LAS f32x4*)(p), w = *(const LAS f32x4*)(p + 2048), bb = *(const LAS f32x4*)(p + 4096), kq = *(const LAS f32x4*)(p + 6144), rr = *(const LAS f32x4*)(p + 8192);
                float vv = pv[0], okeep = 0.f;
#pragma unroll 1
                for (int t4 = 0; t4 < 32; t4 += 4) {
#pragma unroll
                for (int tq = 0; tq < 4; ++tq) {
                    const int tt = t4 + tq;
                    const int tn = (tt + 1 < 32) ? tt + 1 : 31;
                    const LAS float* pn = p + tn * 64;
                    const f32x4 kk_n = *(const LAS f32x4*)(pn), w_n = *(const LAS f32x4*)(pn + 2048), bb_n = *(const LAS f32x4*)(pn + 4096), kq_n = *(const LAS f32x4*)(pn + 6144), rr_n = *(const LAS f32x4*)(pn + 8192);
                    const float vv_n = pv[tn * 16];
                    asm volatile("" ::: "memory");
                    float d = (s.x * kk.x + s.y * kk.y) + (s.z * kk.z + s.w * kk.w);
                    d = -dsum16(d);
                    s.x = s.x * w.x + d * bb.x + vv * kq.x; s.y = s.y * w.y + d * bb.y + vv * kq.y; s.z = s.z * w.z + d * bb.z + vv * kq.z; s.w = s.w * w.w + d * bb.w + vv * kq.w;
                    float o = (s.x * rr.x + s.y * rr.y) + (s.z * rr.z + s.w * rr.w);
                    o = dsum16(o);
                    okeep = (sub == (tt & 15)) ? o : okeep;
                    if (tq == 3 && (t4 & 12) == 12) op[(size_t)(t4 - 12) * 512] = okeep;
                    kk = kk_n; w = w_n; bb = bb_n; kq = kq_n; rr = rr_n; vv = vv_n;
                } }
            }
            __syncthreads();
        }
    }
}
__device__ __forceinline__ void p3b_norm(const Frame& F, const Args& A) {
    const bf16* Z = (const bf16*)(A.ws + WS_Z); bf16* Y = (bf16*)(A.ws + WS_Y);
    const float* OB = A.out; const float* G = (const float*)(A.ws + WS_AUX2); const float* BON = (const float*)(A.ws + WS_BON);
    const int c4 = (F.tid & 127) * 4, h = c4 >> 6;
    const f32x4 muv = *(const f32x4*)(A.in[I_MU] + 1024 + c4), lnw = *(const f32x4*)(A.in[I_LNW] + c4), lnb = *(const f32x4*)(A.in[I_LNB] + c4);
    for (int m = blockIdx.x * 4 + (F.tid >> 7); m < M; m += F.G * 4) {
        const f32x4 o4 = *(const f32x4*)(OB + (size_t)m * 512 + c4), g4 = *(const f32x4*)(G + (size_t)m * 512 + c4);
        const us4 vc = *(const us4*)(Z + (size_t)m * DIN + ZV + c4); us4 vp = {0, 0, 0, 0};
        if ((m % SEQ) > 0) vp = *(const us4*)(Z + (size_t)(m - 1) * DIN + ZV + c4);
        const float bon = BON[(size_t)m * HEADS + h];
        const float mean = dsum16((o4.x + o4.y) + (o4.z + o4.w)) * (1.f / 64.f);
        const f32x4 dd = o4 - mean;
        const float var = dsum16((dd.x * dd.x + dd.y * dd.y) + (dd.z * dd.z + dd.w * dd.w)) * (1.f / 64.f);
        const float rstd = rsqrtf(var + LN_X_EPS);
        float yv[4];
#pragma unroll
        for (int q = 0; q < 4; ++q) { const float vcq = bf2f(vc[q]); const float vv = vcq + (bf2f(vp[q]) - vcq) * muv[q]; yv[q] = (dd[q] * rstd * lnw[q] + lnb[q] + bon * vv) * g4[q]; }
        v2u o; o.x = pk2(yv[0], yv[1]); o.y = pk2(yv[2], yv[3]);
        *(v2u*)(Y + (size_t)m * D + DCONV + c4) = o;
    }
}
__device__ __forceinline__ void p5_router(const Frame& F, const Args& A, bool commit) {
    const int gw = blockIdx.x * NWAVES + F.wave, NGW = F.G * NWAVES;
    const float* H1 = A.out; const float* WrT = (const float*)(A.ws + WS_WRT);
    int* tok_e = (int*)(A.ws + WS_TOK); int* tok_r0 = tok_e + M; int* tok_r1 = tok_e + 2 * M; float* tok_g0 = (float*)(tok_e + 3 * M); float* tok_g1 = (float*)(tok_e + 4 * M); float* tok_rs = (float*)(tok_e + 5 * M);
    const f32x4* gf4 = (const f32x4*)A.in[I_GFFN] + F.lane;
    LAS float* lsc = (LAS float*)(F.lds + F.wave * 16384);
    for (int m0 = gw * 4; m0 < M; m0 += NGW * 4) {
        f32x4 v[4][4]; float rsv[4];
#pragma unroll
        for (int r = 0; r < 4; ++r) {
            const f32x4* hr = (const f32x4*)(H1 + (size_t)(m0 + r) * D) + F.lane; float s = 0.f;
#pragma unroll
            for (int j = 0; j < 4; ++j) { v[r][j] = hr[64 * j]; s += (v[r][j].x * v[r][j].x + v[r][j].y * v[r][j].y) + (v[r][j].z * v[r][j].z + v[r][j].w * v[r][j].w); }
            rsv[r] = rsqrtf(wave_sum(s) * (1.f / D) + RMS_EPS);
#pragma unroll
            for (int j = 0; j < 4; ++j) v[r][j] = v[r][j] * rsv[r] * gf4[64 * j];
        }
#pragma unroll 2
        for (int n = 0; n < 36; ++n) {
            const f32x4* w = (const f32x4*)(WrT + (size_t)n * D) + F.lane;
            const f32x4 w0 = w[0], w1 = w[64], w2 = w[128], w3 = w[192];
#pragma unroll
            for (int r = 0; r < 4; ++r) {
                float p = (v[r][0].x * w0.x + v[r][0].y * w0.y) + (v[r][0].z * w0.z + v[r][0].w * w0.w);
                p += (v[r][1].x * w1.x + v[r][1].y * w1.y) + (v[r][1].z * w1.z + v[r][1].w * w1.w);
                p += (v[r][2].x * w2.x + v[r][2].y * w2.y) + (v[r][2].z * w2.z + v[r][2].w * w2.w);
                p += (v[r][3].x * w3.x + v[r][3].y * w3.y) + (v[r][3].z * w3.z + v[r][3].w * w3.w);
                p = dsum16(p);
                if ((F.lane & 15) == 0) lsc[(r * 36 + n) * 4 + (F.lane >> 4)] = p;
            }
        }
        LDS_WAIT(); asm volatile("" ::: "memory");
#pragma unroll
        for (int r = 0; r < 4; ++r) {
            const int m = m0 + r; const float rs = rsv[r];
            float lg[36];
#pragma unroll
            for (int n = 0; n < 36; ++n) { const f32x4 q = *(const LAS f32x4*)(lsc + (r * 36 + n) * 4); lg[n] = (q.x + q.y) + (q.z + q.w); }
#pragma unroll
        for (int n = 0; n < NG; ++n) lg[n] += A.in[I_RGB][n];
#pragma unroll
        for (int n = 0; n < NE; ++n) lg[NG + n] += A.in[I_REB][n];
        float gmax = lg[0]; int gi = 0;
#pragma unroll
        for (int j = 1; j < NG; ++j) if (lg[j] > gmax) { gmax = lg[j]; gi = j; }
        float gsum = 0.f;
#pragma unroll
        for (int j = 0; j < NG; ++j) gsum += __expf(lg[j] - gmax);
        const float gprob = 1.0f / gsum;
        float ig[EPG];
#pragma unroll
        for (int j = 0; j < EPG; ++j) ig[j] = (gi == 0) ? lg[NG + j] : ((gi == 1) ? lg[NG + 8 + j] : ((gi == 2) ? lg[NG + 16 + j] : lg[NG + 24 + j]));
        float l0 = ig[0]; int i0 = 0;
#pragma unroll
        for (int j = 1; j < EPG; ++j) if (ig[j] > l0) { l0 = ig[j]; i0 = j; }
        float l1 = -3.0e38f; int i1 = 0;
#pragma unroll
        for (int j = 0; j < EPG; ++j) if (j != i0 && ig[j] > l1) { l1 = ig[j]; i1 = j; }
        const float p0 = 1.0f / (1.0f + __expf(l1 - l0)), p1 = 1.0f - p0;
        if (F.lane == 0 && commit) {
            const int e0 = gi * EPG + i0, e1 = gi * EPG + i1;
            const int r0 = (int)atomicAdd(F.ctl + CW_CNT + 64 * e0, 1u), r1 = (int)atomicAdd(F.ctl + CW_CNT + 64 * e1, 1u);
            tok_e[m] = e0 | (e1 << 8); tok_r0[m] = r0; tok_r1[m] = r1; tok_g0[m] = gprob * p0; tok_g1[m] = gprob * p1; tok_rs[m] = rs;
        }
        }
        LDS_WAIT(); asm volatile("" ::: "memory");
    }
    LAS float* scr = (LAS float*)(F.lds + F.wave * 16384);
    bf16* WGU = (bf16*)(A.ws + WS_WGU); bf16* WDt = (bf16*)(A.ws + WS_WD);
    constexpr int IPE = (D / 64) * (DE / 32);
    for (int it = gw; it < 3 * NE * IPE; it += NGW) {
        const int which = it / (NE * IPE), r = it % (NE * IPE), e = r / IPE, q = r % IPE;
        if (which < 2) { const int kb = q / (DE / 32), nb = q % (DE / 32), n0 = 32 * nb;
            transpose_item(A.in[which == 0 ? I_EWG : I_EWU] + (size_t)e * D * DE, DE, 64 * kb, n0, WGU, D, e * 512 + 256 * (n0 >> 7) + (n0 & 127) + (which == 1 ? 128 : 0), scr, F.lane); }
        else { const int kb = q / (D / 32), nb = q % (D / 32);
            transpose_item(A.in[I_EWD] + (size_t)e * DE * D, D, 64 * kb, 32 * nb, WDt, DE, e * D + 32 * nb, scr, F.lane); }
    }
}
__device__ __forceinline__ void load_offsets(const Frame& F, const Args& A) {
    LAS int* offs = (LAS int*)(F.lds + OFFS_OFF);
    if (F.tid == 0) { int o = 0;
        for (int e = 0; e < NE; ++e) { offs[e] = o; const int c = (int)__hip_atomic_load(F.ctl + CW_CNT + 64 * e, __ATOMIC_RELAXED, __HIP_MEMORY_SCOPE_AGENT); o += (c + 255) & ~255; }
        offs[NE] = o; }
    __syncthreads();
}
__device__ __forceinline__ void p6a_gather(const Frame& F, const Args& A) {
    load_offsets(F, A);
    const LAS int* offs = (const LAS int*)(F.lds + OFFS_OFF);
    const int gw = blockIdx.x * NWAVES + F.wave, NGW = F.G * NWAVES;
    const float* H1 = A.out; bf16* XS = (bf16*)(A.ws + WS_XS);
    const int* tok_e = (const int*)(A.ws + WS_TOK); const int* tok_r0 = tok_e + M; const int* tok_r1 = tok_e + 2 * M; const float* tok_rs = (const float*)(tok_e + 5 * M);
    int* tok_s0 = (int*)(A.ws + WS_TOK) + 6 * M; int* tok_s1 = tok_s0 + M;
    const f32x4* gf4 = (const f32x4*)A.in[I_GFFN] + F.lane;
    for (int m = gw; m < M; m += NGW) {
        const int ee = tok_e[m], e0 = ee & 255, e1 = (ee >> 8) & 255;
        const int s0 = offs[e0] + tok_r0[m], s1 = offs[e1] + tok_r1[m];
        const float rs = tok_rs[m];
        const f32x4* hr = (const f32x4*)(H1 + (size_t)m * D) + F.lane;
        v2u* o0 = (v2u*)(XS + (size_t)s0 * D) + F.lane; v2u* o1 = (v2u*)(XS + (size_t)s1 * D) + F.lane;
#pragma unroll
        for (int j = 0; j < 4; ++j) { const f32x4 v = hr[64 * j] * rs * gf4[64 * j]; v2u o; o.x = pk2(v.x, v.y); o.y = pk2(v.z, v.w); o0[64 * j] = o; o1[64 * j] = o; }
        if (F.lane == 0) { tok_s0[m] = s0; tok_s1[m] = s1; }
    }
}
__device__ __forceinline__ void p7_final(const Frame& F, const Args& A, float* outp) {
    const int gw = blockIdx.x * NWAVES + F.wave, NGW = F.G * NWAVES;
    const bf16* SO = (const bf16*)(A.ws + WS_SOUT);
    const int* tok_e = (const int*)(A.ws + WS_TOK); const float* tok_g0 = (const float*)(tok_e + 3 * M); const float* tok_g1 = (const float*)(tok_e + 4 * M);
    const int* tok_s0 = tok_e + 6 * M; const int* tok_s1 = tok_s0 + M;
    const f32x4* gf4 = (const f32x4*)A.in[I_GFIN] + F.lane;
    for (int m = gw; m < M; m += NGW) {
        const int s0 = tok_s0[m], s1 = tok_s1[m]; const float g0 = tok_g0[m], g1 = tok_g1[m];
        const f32x4* hr = (const f32x4*)(A.out + (size_t)m * D) + F.lane; f32x4* orow = (f32x4*)(outp + (size_t)m * D) + F.lane;
        const v2u* a0 = (const v2u*)(SO + (size_t)s0 * D) + F.lane; const v2u* a1 = (const v2u*)(SO + (size_t)s1 * D) + F.lane;
        f32x4 v[4]; float s = 0.f;
#pragma unroll
        for (int j = 0; j < 4; ++j) { const v2u x0 = a0[64 * j], x1 = a1[64 * j]; f32x4 h = hr[64 * j];
            h.x += g0 * bf2f((unsigned short)(x0.x & 0xffffu)) + g1 * bf2f((unsigned short)(x1.x & 0xffffu)); h.y += g0 * bf2f((unsigned short)(x0.x >> 16)) + g1 * bf2f((unsigned short)(x1.x >> 16));
            h.z += g0 * bf2f((unsigned short)(x0.y & 0xffffu)) + g1 * bf2f((unsigned short)(x1.y & 0xffffu)); h.w += g0 * bf2f((unsigned short)(x0.y >> 16)) + g1 * bf2f((unsigned short)(x1.y >> 16));
            v[j] = h; s += (h.x * h.x + h.y * h.y) + (h.z * h.z + h.w * h.w); }
        const float rs = rsqrtf(wave_sum(s) * (1.f / D) + RMS_EPS);
#pragma unroll
        for (int j = 0; j < 4; ++j) orow[64 * j] = v[j] * rs * gf4[64 * j];
    }
}

__global__ void __launch_bounds__(NTHREADS, 2) fwd_kernel(Args args) {
    extern __shared__ __attribute__((aligned(16))) unsigned char lds_raw[];
    Frame F;
    F.lds = (LAS unsigned char*)lds_raw;
    F.tid = threadIdx.x; F.lane = F.tid & 63; F.wave = __builtin_amdgcn_readfirstlane(F.tid >> 6); F.G = gridDim.x;
    F.ctl = (unsigned*)(args.ws + WS_CTL);
    const Args& A = args;
    volatile LAS unsigned* MISC = (volatile LAS unsigned*)(F.lds + MISC_OFF);
    for (int u = F.tid; u < (LDS_BYTES - RING_BYTES) / 4; u += NTHREADS) ((LAS unsigned*)(F.lds + RING_BYTES))[u] = 0u;
    __syncthreads();
    const int lo = args.ph_lo, hi = args.ph_hi;
    XcdBarrier bar; bar.bar = F.ctl + CW_BAR; bar.x = 0; bar.st = nullptr;
    if (hi - lo > 1) bar = xcd_barrier_post(F.ctl + CW_BAR, MISC + 8);
#define IN(k) (lo <= (k) && (k) < hi)
#ifndef PH_MASK
#define PH_MASK 0xfff
#endif
#define PH_EN(k) (((PH_MASK) >> (k)) & 1)
#ifndef PH_DUP
#define PH_DUP 0
#endif
#define REP(k) for (int rep_ = 0; rep_ < 1 + (((PH_DUP) >> (k)) & 1); ++rep_)
#define SEAM(k) do { if (IN(k) && IN((k) + 1)) xcd_barrier(bar); } while (0)
    if (PH_EN(0) && IN(0)) REP(0) { p0_prologue(F, A); } SEAM(0);
    if (PH_EN(1) && IN(1)) REP(1) {
        pg8::Gemm g{(const pg8::bf16_t*)(A.ws + WS_XN), (const pg8::bf16_t*)(A.ws + WS_WIN), M, DIN, D}; pg8::StaticOrder S; S.init(M, DIN, F.G, (int)blockIdx.x);
        pg8::EpiBf16<0> E{(pg8::bf16_t*)(A.ws + WS_Z), DIN, nullptr, 0, 0, 1.f};
        pg8::gemm_phase<pg8::EpiBf16<0>, pg8::StaticOrder, true, true>(F.lds, g, S, E);
    } SEAM(1);
    if (PH_EN(2) && IN(2)) REP(2) { p2a_mix(F, A); } SEAM(2);
    if (PH_EN(3) && IN(3)) REP(3) {
        pg8::Gemm g{(const pg8::bf16_t*)(A.ws + WS_LIN), (const pg8::bf16_t*)(A.ws + WS_W3), M, 1536, 256}; pg8::StaticOrder S; S.init(M, 1536, F.G, (int)blockIdx.x);
        pg8::EpiLora E{(float*)(A.ws + WS_AUX0), A.in[I_DECBASE], A.in[I_ABASE], (WS_AUX1 - WS_AUX0) / 4, (WS_AUX2 - WS_AUX0) / 4};
        pg8::gemm_phase<pg8::EpiLora, pg8::StaticOrder, true, true>(F.lds, g, S, E);
    } SEAM(3);
    if (PH_EN(4) && IN(4)) REP(4) { p3_rwkv(F, A); } SEAM(4);
    if (PH_EN(5) && IN(5)) REP(5) { p3b_norm(F, A); } SEAM(5);
    if (PH_EN(6) && IN(6)) REP(6) {
        pg8::Gemm g{(const pg8::bf16_t*)(A.ws + WS_Y), (const pg8::bf16_t*)(A.ws + WS_WOUT), M, D, D}; pg8::StaticOrder S; S.init(M, D, F.G, (int)blockIdx.x);
        pg8::EpiResF32 E{A.in[I_X], A.out, D};
        pg8::gemm_phase<pg8::EpiResF32, pg8::StaticOrder, true, true>(F.lds, g, S, E);
    } SEAM(6);
    if (PH_EN(7) && IN(7)) REP(7) { p5_router(F, A, rep_ == (((PH_DUP) >> 7) & 1)); } SEAM(7);
    if (PH_EN(8) && IN(8)) REP(8) { p6a_gather(F, A); } SEAM(8);
    if (PH_EN(9) && IN(9)) REP(9) {
        load_offsets(F, A);
        pg8::Gemm g{(const pg8::bf16_t*)(A.ws + WS_XS), (const pg8::bf16_t*)(A.ws + WS_WGU), MAXSLOTS, 512, D};
        pg8::MoeOrder S; S.init((const LAS int*)(F.lds + OFFS_OFF), 2, F.G, (int)blockIdx.x, (size_t)512 * D * 2);
        pg8::EpiSwiGLU E{(pg8::bf16_t*)(A.ws + WS_HID), DE};
        pg8::gemm_phase<pg8::EpiSwiGLU, pg8::MoeOrder, true, true>(F.lds, g, S, E);
    } SEAM(9);
    if (PH_EN(10) && IN(10)) REP(10) {
        load_offsets(F, A);
        pg8::Gemm g{(const pg8::bf16_t*)(A.ws + WS_HID), (const pg8::bf16_t*)(A.ws + WS_WD), MAXSLOTS, D, DE};
        pg8::MoeOrder S; S.init((const LAS int*)(F.lds + OFFS_OFF), 4, F.G, (int)blockIdx.x, (size_t)D * DE * 2);
        pg8::EpiBf16<0> E{(pg8::bf16_t*)(A.ws + WS_SOUT), D, nullptr, 0, 0, 1.f};
        pg8::gemm_phase<pg8::EpiBf16<0>, pg8::MoeOrder, true, true>(F.lds, g, S, E);
    } SEAM(10);
    if (PH_EN(11) && IN(11)) REP(11) { p7_final(F, A, (rep_ == (((PH_DUP) >> 11) & 1)) ? A.out : (float*)(A.ws + WS_XS)); }
#undef IN
#undef SEAM
}

extern "C" void kernel_launch(void* const* d_in, const int* in_sizes, int n_in, void* d_out, int out_size, void* d_ws, size_t ws_size, hipStream_t stream) {
    static int grid = 0;
    if (grid == 0) {
        if (n_in != 25 || in_sizes[0] != M * D || out_size != M * D || ws_size < WS_END) { fprintf(stderr, "kernel_launch: unexpected shapes (n_in %d, in0 %d, out %d, ws %zu)\n", n_in, n_in > 0 ? in_sizes[0] : -1, out_size, ws_size); grid = -1; return; }
        int dev = 0, cus = 0, per_cu = 0;
        if (hipGetDevice(&dev) != hipSuccess || hipDeviceGetAttribute(&cus, hipDeviceAttributeMultiprocessorCount, dev) != hipSuccess) { grid = -1; return; }
        if (hipFuncSetAttribute((const void*)fwd_kernel, hipFuncAttributeMaxDynamicSharedMemorySize, LDS_BYTES) != hipSuccess) { fprintf(stderr, "kernel_launch: hipFuncSetAttribute failed\n"); grid = -1; return; }
        if (hipOccupancyMaxActiveBlocksPerMultiprocessor(&per_cu, (const void*)fwd_kernel, NTHREADS, LDS_BYTES) != hipSuccess || per_cu < 1) { fprintf(stderr, "kernel_launch: occupancy query says %d blocks per CU\n", per_cu); per_cu = 1; }
        (void)hipGetLastError();
        grid = cus;
    }
    if (grid < 0) return;
    (void)hipMemsetAsync((char*)d_ws + WS_CTL, 0, CTL_ZERO_BYTES, stream);
    Args a{};
    for (int i = 0; i < 25; ++i) a.in[i] = (const float*)d_in[i];
    a.out = (float*)d_out; a.ws = (unsigned char*)d_ws;
#if MK_N_LAUNCHES == 1
    a.ph_lo = 0; a.ph_hi = NPHASES;
    void* kargs[] = {&a};
    hipError_t e = hipLaunchCooperativeKernel((const void*)fwd_kernel, dim3(grid), dim3(NTHREADS), kargs, LDS_BYTES, stream);
    if (e != hipSuccess) fprintf(stderr, "kernel_launch: cooperative launch failed: %s (grid %d)\n", hipGetErrorString(e), grid);
#else
    for (int p = 0; p < NPHASES; ++p) { a.ph_lo = p; a.ph_hi = p + 1; hipLaunchKernelGGL(fwd_kernel, dim3(grid), dim3(NTHREADS), LDS_BYTES, stream, a); }
#endif
}
```

```cpp
#include <hip/hip_runtime.h>
#include <cstdio>
#include <cstdint>
namespace pg8 {
#define PG8_LAS __attribute__((address_space(3)))
typedef unsigned short bf16_t;
typedef short bf16x8 __attribute__((ext_vector_type(8)));
typedef float f32x4 __attribute__((ext_vector_type(4)));
typedef unsigned u32x4 __attribute__((ext_vector_type(4)));
constexpr int BM = 256, BK = 64, HALF = 128, HTB = HALF * BK * 2  , STAGE_BYTES = 8 * HTB, NXCD = 8, WGM = 8;

__host__ __device__ __forceinline__ int lds_byte(int r, int c) { const int st = (r >> 4) * 2 + (c >> 5), rr = r & 15, cc = c & 31, ob = rr * 64 + cc * 2; return st * 1024 + (ob ^ (((ob >> 9) & 1) << 5)); }
__host__ __device__ __forceinline__ void stage_rc(int b, int& R, int& C) { const int st = b / 1024, sb = b % 1024, swz = sb ^ (((sb >> 9) & 1) << 5); R = (st >> 1) * 16 + swz / 64; C = (st & 1) * 32 + (swz % 64) / 2; }
__host__ __device__ __forceinline__ int perm32(int rho) { const int n = rho >> 4, i = rho & 15; return 8 * (i >> 2) + 4 * n + (i & 3); }


struct Unit { int pm, pn, e; };
struct Gemm { const bf16_t* A; const bf16_t* Bt; int M, N, K; };

struct StaticOrder {
    int nM, nN, nwg, G, c;
    __host__ __device__ void init(int M, int N, int G_, int c_) { nM = M / BM; nN = N / BM; nwg = nM * nN; G = G_; c = c_; }
    __host__ __device__ bool next(int i, Unit& u) const {
        const long L = (long)i * G + c; if (L >= nwg) return false;
        int wgid = (int)L; { const int q = nwg / NXCD, r = nwg % NXCD, xcd = wgid % NXCD, off = wgid / NXCD; wgid = (xcd < r ? xcd * (q + 1) : r * (q + 1) + (xcd - r) * q) + off; }
        const int nig = WGM * nN, gid = wgid / nig, fm = gid * WGM, gsz = (nM - fm) < WGM ? (nM - fm) : WGM;
        u.pm = fm + ((wgid % nig) % gsz); u.pn = (wgid % nig) / gsz; u.e = 0; return true;
    }
    __device__ __forceinline__ const char* a_ptr(const Gemm& g, const Unit& u, size_t tstep) const { return (const char*)g.A + (size_t)u.pm * tstep; }
    __device__ __forceinline__ const char* b_ptr(const Gemm& g, const Unit& u, size_t tstep) const { return (const char*)g.Bt + (size_t)u.pn * tstep; }
    __device__ __forceinline__ void a_ready(const Unit&) const {}
    __device__ __forceinline__ void done(const Unit&) const {}
};
struct MoeOrder {
    const PG8_LAS int* off; int nct, nunits, G, c; size_t estride;
    __device__ __forceinline__ void init(const PG8_LAS int* off_, int nct_, int G_, int c_, size_t estride_) {
        off = off_; nct = nct_; G = G_; c = c_; estride = estride_; nunits = __builtin_amdgcn_readfirstlane((off_[32] >> 8) * nct_); }
    __device__ __forceinline__ bool next(int i, Unit& u) const {
        const int L = i * G + c; if (L >= nunits) return false;
        const int rt = L / nct, ct = L - rt * nct;
        u.pm = rt; u.pn = ct; u.e = __builtin_amdgcn_readfirstlane(off[64 + rt]); return true;
    }
    __device__ __forceinline__ const char* a_ptr(const Gemm& g, const Unit& u, size_t tstep) const { return (const char*)g.A + (size_t)u.pm * tstep; }
    __device__ __forceinline__ const char* b_ptr(const Gemm& g, const Unit& u, size_t tstep) const { return (const char*)g.Bt + (size_t)u.e * estride + (size_t)u.pn * tstep; }
    __device__ __forceinline__ void a_ready(const Unit&) const {}
    __device__ __forceinline__ void done(const Unit&) const {}
};

__device__ __forceinline__ unsigned cvt_pk_bf16(float lo, float hi) { unsigned r; asm volatile("v_cvt_pk_bf16_f32 %0, %1, %2" : "=v"(r) : "v"(lo), "v"(hi)); return r; }
template <int ACT  > struct EpiBf16 {
    static constexpr bool PERM = true, AFTER_DRAIN = false; static_assert(ACT == 0, "EpiBf16: ACT is 0 (none)");
    bf16_t* O; int ldc; const float* bias; int split_cols; size_t split_stride; float scale0;
    __device__ __forceinline__ void operator()(const f32x4 (&acc)[2][2][4][2], const Unit& u, int wr, int wc, int fr, int fq) const {
        const int row0 = u.pm * BM + wr * 64 + fr; int colt = u.pn * BM; bf16_t* base = O;
        float sc = 1.f; if (split_cols) { const int t = colt / split_cols; base += (size_t)t * split_stride; colt -= t * split_cols; if (t == 0) sc = scale0; }
        const int col0 = colt + wc * 32 + 8 * fq, bcol0 = u.pn * BM + wc * 32 + 8 * fq;
        f32x4 bv[2][2];
#pragma unroll
        for (int bj = 0; bj < 2; ++bj)
#pragma unroll
            for (int n = 0; n < 2; ++n) bv[bj][n] = bias ? *(const f32x4*)(bias + bcol0 + bj * HALF + 4 * n) : (f32x4){0.f, 0.f, 0.f, 0.f};
#pragma unroll
        for (int ai = 0; ai < 2; ++ai)
#pragma unroll
            for (int m = 0; m < 4; ++m) { bf16_t* rowp = base + (size_t)(row0 + ai * HALF + m * 16) * ldc + col0;
#pragma unroll
                for (int bj = 0; bj < 2; ++bj) { f32x4 v0 = acc[ai][bj][m][0] + bv[bj][0], v1 = acc[ai][bj][m][1] + bv[bj][1];
                    v0 = v0 * sc; v1 = v1 * sc; u32x4 w; w.x = cvt_pk_bf16(v0[0], v0[1]); w.y = cvt_pk_bf16(v0[2], v0[3]); w.z = cvt_pk_bf16(v1[0], v1[1]); w.w = cvt_pk_bf16(v1[2], v1[3]);
                    *(u32x4*)(rowp + bj * HALF) = w; } }
    }
};
struct EpiResF32 {
    static constexpr bool PERM = false, AFTER_DRAIN = false;
    const float* base; float* C; int ldc;
    __device__ __forceinline__ void operator()(const f32x4 (&acc)[2][2][4][2], const Unit& u, int wr, int wc, int fr, int fq) const {
        const int row0 = u.pm * BM + wr * 64 + fr, col0 = u.pn * BM + wc * 32 + 4 * fq;
#pragma unroll
        for (int ai = 0; ai < 2; ++ai)
#pragma unroll
            for (int m = 0; m < 4; ++m) { const size_t o = (size_t)(row0 + ai * HALF + m * 16) * ldc + col0;
#pragma unroll
                for (int bj = 0; bj < 2; ++bj)
#pragma unroll
                    for (int n = 0; n < 2; ++n) *(f32x4*)(C + o + bj * HALF + n * 16) = acc[ai][bj][m][n] + *(const f32x4*)(base + o + bj * HALF + n * 16); }
    }
};
__device__ __forceinline__ float silu_f(float x) { return x * __builtin_amdgcn_rcpf(1.0f + __builtin_amdgcn_exp2f(-1.4426950408889634f * x)); }
struct EpiSwiGLU {
    static constexpr bool PERM = true, AFTER_DRAIN = false;
    bf16_t* H; int ldc;
    __device__ __forceinline__ void operator()(const f32x4 (&acc)[2][2][4][2], const Unit& u, int wr, int wc, int fr, int fq) const {
        const int row0 = u.pm * BM + wr * 64 + fr, col0 = u.pn * HALF + wc * 32 + 8 * fq;
#pragma unroll
        for (int ai = 0; ai < 2; ++ai)
#pragma unroll
            for (int m = 0; m < 4; ++m) { bf16_t* rowp = H + (size_t)(row0 + ai * HALF + m * 16) * ldc + col0;
                const f32x4 g0 = acc[ai][0][m][0], g1 = acc[ai][0][m][1], u0 = acc[ai][1][m][0], u1 = acc[ai][1][m][1];
                u32x4 w; w.x = cvt_pk_bf16(silu_f(g0[0]) * u0[0], silu_f(g0[1]) * u0[1]); w.y = cvt_pk_bf16(silu_f(g0[2]) * u0[2], silu_f(g0[3]) * u0[3]);
                w.z = cvt_pk_bf16(silu_f(g1[0]) * u1[0], silu_f(g1[1]) * u1[1]); w.w = cvt_pk_bf16(silu_f(g1[2]) * u1[2], silu_f(g1[3]) * u1[3]);
                *(u32x4*)rowp = w; }
    }
};

struct EpiPlainBf16 {
    static constexpr bool PERM = true, AFTER_DRAIN = false;
    bf16_t* O; int ldc;
    __device__ __forceinline__ void operator()(const f32x4 (&acc)[2][2][4][2], const Unit& u, int wr, int wc, int fr, int fq) const {
        bf16_t* base = O + (size_t)(u.pm * BM + wr * 64 + fr) * ldc + u.pn * BM + wc * 32 + 8 * fq;
#pragma unroll
        for (int ai = 0; ai < 2; ++ai)
#pragma unroll
            for (int m = 0; m < 4; ++m)
#pragma unroll
                for (int bj = 0; bj < 2; ++bj) { const f32x4 v0 = acc[ai][bj][m][0], v1 = acc[ai][bj][m][1];
                    u32x4 w; w.x = cvt_pk_bf16(v0[0], v0[1]); w.y = cvt_pk_bf16(v0[2], v0[3]); w.z = cvt_pk_bf16(v1[0], v1[1]); w.w = cvt_pk_bf16(v1[2], v1[3]);
                    *(u32x4*)(base + (size_t)(ai * HALF + m * 16) * ldc + bj * HALF) = w; }
    }
};
struct EpiZ {
    static constexpr bool PERM = true, AFTER_DRAIN = false;
    bf16_t* ZC; bf16_t* ZR;
    __device__ __forceinline__ void operator()(const f32x4 (&acc)[2][2][4][2], const Unit& u, int wr, int wc, int fr, int fq) const {
        const bool conv = u.pn < 6; bf16_t* base = conv ? ZC : ZR; const int ldc = conv ? 1536 : 1792;
        const int row0 = u.pm * BM + wr * 64 + fr, col0 = (conv ? u.pn : u.pn - 6) * BM + wc * 32 + 8 * fq;
#pragma unroll
        for (int ai = 0; ai < 2; ++ai)
#pragma unroll
            for (int m = 0; m < 4; ++m) { bf16_t* rowp = base + (size_t)(row0 + ai * HALF + m * 16) * ldc + col0;
#pragma unroll
                for (int bj = 0; bj < 2; ++bj) { const f32x4 v0 = acc[ai][bj][m][0], v1 = acc[ai][bj][m][1];
                    u32x4 w; w.x = cvt_pk_bf16(v0[0], v0[1]); w.y = cvt_pk_bf16(v0[2], v0[3]); w.z = cvt_pk_bf16(v1[0], v1[1]); w.w = cvt_pk_bf16(v1[2], v1[3]);
                    *(u32x4*)(rowp + bj * HALF) = w; } }
    }
};
struct EpiLora {
    static constexpr bool PERM = true, AFTER_DRAIN = false;
    bf16_t* LAM; bf16_t* AA; bf16_t* GG; const float* base0; const float* base1;
    __device__ __forceinline__ void operator()(const f32x4 (&acc)[2][2][4][2], const Unit& u, int wr, int wc, int fr, int fq) const {
        const int which = u.pn >> 1, row0 = u.pm * BM + wr * 64 + fr, colb = (u.pn & 1) * BM + wc * 32 + 8 * fq;
        if (which < 2) {
            bf16_t* O = ((which == 0) ? LAM : AA) + (size_t)row0 * 512 + colb; const float* bs = ((which == 0) ? base0 : base1) + colb; const float sc = (which == 0) ? 0.6065306597126334f : 1.0f;
#pragma unroll
            for (int ai = 0; ai < 2; ++ai)
#pragma unroll
                for (int m = 0; m < 4; ++m)
#pragma unroll
                    for (int bj = 0; bj < 2; ++bj)
#pragma unroll
                        for (int n = 0; n < 2; ++n) { f32x4 v = acc[ai][bj][m][n] + *(const f32x4*)(bs + bj * HALF + 4 * n);
#pragma unroll
                            for (int i = 0; i < 4; ++i) v[i] = sc * __builtin_amdgcn_rcpf(1.0f + __builtin_amdgcn_exp2f(-1.4426950408889634f * v[i]));
                            unsigned* d = (unsigned*)(O + (size_t)(ai * HALF + m * 16) * 512 + bj * HALF + 4 * n); d[0] = cvt_pk_bf16(v[0], v[1]); d[1] = cvt_pk_bf16(v[2], v[3]); }
        } else {
            bf16_t* gb = GG + ((size_t)(u.pm * 4 + wr) * 8 + (colb >> 6)) * 4096 + ((((colb & 63) >> 4) * 64) + (((colb & 15) >> 2) * 16) + fr) * 4;
#pragma unroll
            for (int ai = 0; ai < 2; ++ai)
#pragma unroll
                for (int m = 0; m < 4; ++m)
#pragma unroll
                    for (int bj = 0; bj < 2; ++bj)
#pragma unroll
                        for (int n = 0; n < 2; ++n) { const f32x4 v = acc[ai][bj][m][n];
                            unsigned* d = (unsigned*)(gb + (size_t)(ai * 2 * 8 + bj * 2) * 4096 + m * 1024 + n * 64); d[0] = cvt_pk_bf16(v[0], v[1]); d[1] = cvt_pk_bf16(v[2], v[3]); }
        }
    }
};

template <class Epi, class Sched, bool ALIGN_EPI = false, bool SP2 = false>
__device__ __forceinline__ void gemm_phase(PG8_LAS unsigned char* lds, const Gemm g, const Sched& S, const Epi& E, const int tid) {
    const int wid = __builtin_amdgcn_readfirstlane(tid >> 6), lane = tid & 63, wr = wid >> 2, wc = wid & 3, fr = lane & 15, fq = lane >> 4;
    const int K = g.K, nt = K / BK;
    unsigned voffA[2], voffB[2];
#pragma unroll
    for (int i = 0; i < 2; ++i) { int R, C; stage_rc(tid * 16 + i * 8192, R, C); const int Rb = Epi::PERM ? ((R & ~31) + perm32(R & 31)) : R;
        voffA[i] = (unsigned)(R * K + C) * 2u; voffB[i] = (unsigned)(Rb * K + C) * 2u; }
    const size_t kstep = (size_t)(BK * 2);
    const size_t hstep = (size_t)HALF * K * 2;
    const size_t tstep = 2 * hstep;
    const unsigned ldsw = (unsigned)wid * 1024u;
    const int aoff = lds_byte(wr * 64 + fr, fq * 8), boff = lds_byte(wc * 32 + fr, fq * 8);
#define PG8_SA(b, h) (((b) * 2 + (h)) * HTB)
#define PG8_SB(b, h) ((4 + (b) * 2 + (h)) * HTB)
#define PG8_STAGE(bufoff, gbase, voff) do { _Pragma("unroll") for (int _i = 0; _i < 2; ++_i) \
        __builtin_amdgcn_global_load_lds((const unsigned*)((const char*)(gbase) + (voff)[_i]), (PG8_LAS unsigned*)(lds + (bufoff) + ldsw + _i * 8192), 16, 0, 0); } while (0)
#define PG8_LDA(dst, b, h) do { _Pragma("unroll") for (int m = 0; m < 4; ++m) _Pragma("unroll") for (int k = 0; k < 2; ++k) dst[m][k] = *(const PG8_LAS bf16x8*)(lds + PG8_SA(b, h) + aoff + m * 2048 + k * 1024); } while (0)
#define PG8_LDB(dst, b, h) do { _Pragma("unroll") for (int n = 0; n < 2; ++n) _Pragma("unroll") for (int k = 0; k < 2; ++k) dst[n][k] = *(const PG8_LAS bf16x8*)(lds + PG8_SB(b, h) + boff + n * 2048 + k * 1024); } while (0)
#define PG8_MMA(ai, bj, At, Bt) do { __builtin_amdgcn_s_setprio(1); _Pragma("unroll") for (int m = 0; m < 4; ++m) _Pragma("unroll") for (int n = 0; n < 2; ++n) _Pragma("unroll") for (int k = 0; k < 2; ++k) \
        acc[ai][bj][m][n] = __builtin_amdgcn_mfma_f32_16x16x32_bf16(Bt[n][k], At[m][k], acc[ai][bj][m][n], 0, 0, 0); __builtin_amdgcn_s_setprio(0); } while (0)
#define PG8_WAIT_V(n) asm volatile("s_waitcnt vmcnt(" #n ")" ::: "memory")
#define PG8_WAIT_L(n) asm volatile("s_waitcnt lgkmcnt(" #n ")" ::: "memory")
#define PG8_BAR __builtin_amdgcn_s_barrier()
#define PG8_SCHED __builtin_amdgcn_sched_barrier(0)
    Unit cur, nxt; int ui = 0;
    if (!S.next(0, cur)) return;
    f32x4 acc[2][2][4][2];
#pragma unroll
    for (int a = 0; a < 2; ++a)
#pragma unroll
        for (int b = 0; b < 2; ++b)
#pragma unroll
            for (int m = 0; m < 4; ++m)
#pragma unroll
                for (int n = 0; n < 2; ++n) acc[a][b][m][n] = (f32x4){0.f, 0.f, 0.f, 0.f};
    bf16x8 At[4][2], B0[2][2], B1[2][2];
    const char* cA = S.a_ptr(g, cur, tstep); const char* cB = S.b_ptr(g, cur, tstep);
    S.a_ready(cur);
    if constexpr (SP2) {
        PG8_STAGE(PG8_SB(0, 0), cB, voffB); PG8_STAGE(PG8_SB(0, 1), cB + hstep, voffB); PG8_STAGE(PG8_SA(0, 0), cA, voffA); PG8_STAGE(PG8_SA(0, 1), cA + hstep, voffA);
        if (wr == 1) PG8_BAR;
        PG8_WAIT_V(2); PG8_BAR;
        PG8_STAGE(PG8_SB(1, 0), cB + kstep, voffB); PG8_STAGE(PG8_SA(1, 0), cA + kstep, voffA); PG8_STAGE(PG8_SB(1, 1), cB + hstep + kstep, voffB);
        PG8_WAIT_V(6); PG8_BAR;
    } else {
        PG8_STAGE(PG8_SB(0, 0), cB, voffB); PG8_STAGE(PG8_SA(0, 0), cA, voffA); PG8_STAGE(PG8_SB(0, 1), cB + hstep, voffB); PG8_STAGE(PG8_SA(0, 1), cA + hstep, voffA);
        if (wr == 1) PG8_BAR;
        PG8_WAIT_V(4); PG8_BAR;
        PG8_STAGE(PG8_SB(1, 0), cB + kstep, voffB); PG8_STAGE(PG8_SA(1, 0), cA + kstep, voffA); PG8_STAGE(PG8_SB(1, 1), cB + hstep + kstep, voffB);
        PG8_WAIT_V(6); PG8_BAR;
    }
    for (;;) {
        const bool has_next = S.next(ui + 1, nxt);
        const char* nA = has_next ? S.a_ptr(g, nxt, tstep) : cA; const char* nB = has_next ? S.b_ptr(g, nxt, tstep) : cB;
        for (int t = 0; t < nt; t += 2) {
            const bool last = (t == nt - 2);
            const char* a1 = cA + (size_t)(t + 1) * kstep;
            const char* a2 = last ? nA : cA + (size_t)(t + 2) * kstep; const char* b2 = last ? nB : cB + (size_t)(t + 2) * kstep;
            const char* a3 = a2 + kstep; const char* b3 = b2 + kstep;
            if (last && has_next) S.a_ready(nxt);
            if constexpr (SP2) {
            PG8_LDB(B0, 0, 0); PG8_LDB(B1, 0, 1); PG8_SCHED; PG8_LDA(At, 0, 0); PG8_STAGE(PG8_SA(1, 1), a1 + hstep, voffA);
            PG8_WAIT_V(8); PG8_WAIT_L(0); PG8_BAR; PG8_MMA(0, 0, At, B0); PG8_MMA(0, 1, At, B1); PG8_BAR; PG8_SCHED;
            PG8_LDA(At, 0, 1); PG8_STAGE(PG8_SB(0, 0), b2, voffB); PG8_STAGE(PG8_SB(0, 1), b2 + hstep, voffB); PG8_STAGE(PG8_SA(0, 0), a2, voffA);
            PG8_WAIT_V(8); PG8_WAIT_L(0); PG8_BAR; PG8_MMA(1, 0, At, B0); PG8_MMA(1, 1, At, B1); PG8_BAR; PG8_SCHED;
            PG8_LDB(B0, 1, 0); PG8_LDB(B1, 1, 1); PG8_SCHED; PG8_LDA(At, 1, 0); PG8_STAGE(PG8_SA(0, 1), a2 + hstep, voffA);
            PG8_WAIT_V(8); PG8_WAIT_L(0); PG8_BAR; PG8_MMA(0, 0, At, B0); PG8_MMA(0, 1, At, B1); PG8_BAR; PG8_SCHED;
            PG8_LDA(At, 1, 1); PG8_STAGE(PG8_SB(1, 0), b3, voffB); PG8_STAGE(PG8_SB(1, 1), b3 + hstep, voffB); PG8_STAGE(PG8_SA(1, 0), a3, voffA);
            PG8_WAIT_V(8); PG8_WAIT_L(0); PG8_BAR; PG8_MMA(1, 0, At, B0); PG8_MMA(1, 1, At, B1); PG8_BAR; PG8_SCHED;
            } else {
            PG8_LDB(B0, 0, 0); PG8_SCHED; PG8_LDA(At, 0, 0); PG8_STAGE(PG8_SA(1, 1), a1 + hstep, voffA);
            PG8_WAIT_L(8); PG8_BAR; PG8_WAIT_L(0); PG8_MMA(0, 0, At, B0); PG8_BAR; PG8_SCHED;
            PG8_LDB(B1, 0, 1); PG8_STAGE(PG8_SB(0, 0), b2, voffB);
            PG8_BAR; PG8_WAIT_L(0); PG8_MMA(0, 1, At, B1); PG8_BAR;
            PG8_LDA(At, 0, 1); PG8_STAGE(PG8_SA(0, 0), a2, voffA);
            PG8_BAR; PG8_WAIT_L(0); PG8_MMA(1, 0, At, B0); PG8_BAR; PG8_SCHED;
            PG8_STAGE(PG8_SB(0, 1), b2 + hstep, voffB);
            PG8_WAIT_V(6); PG8_BAR; PG8_MMA(1, 1, At, B1); PG8_BAR;
            PG8_LDB(B0, 1, 0); PG8_SCHED; PG8_LDA(At, 1, 0); PG8_STAGE(PG8_SA(0, 1), a2 + hstep, voffA);
            PG8_WAIT_L(8); PG8_BAR; PG8_WAIT_L(0); PG8_MMA(0, 0, At, B0); PG8_BAR; PG8_SCHED;
            PG8_LDB(B1, 1, 1); PG8_STAGE(PG8_SB(1, 0), b3, voffB);
            PG8_BAR; PG8_WAIT_L(0); PG8_MMA(0, 1, At, B1); PG8_BAR;
            PG8_LDA(At, 1, 1); PG8_STAGE(PG8_SA(1, 0), a3, voffA);
            PG8_BAR; PG8_WAIT_L(0); PG8_MMA(1, 0, At, B0); PG8_BAR; PG8_SCHED;
            PG8_STAGE(PG8_SB(1, 1), b3 + hstep, voffB);
            PG8_WAIT_V(6); PG8_BAR; PG8_MMA(1, 1, At, B1); PG8_BAR;
            }
        }
        if constexpr (ALIGN_EPI) { if (wr == 0) PG8_BAR; }
        if constexpr (!Epi::AFTER_DRAIN) { E(acc, cur, wr, wc, fr, fq); S.done(cur); }
        if (!has_next) break;
#pragma unroll
        for (int a = 0; a < 2; ++a)
#pragma unroll
            for (int b = 0; b < 2; ++b)
#pragma unroll
                for (int m = 0; m < 4; ++m)
#pragma unroll
                    for (int n = 0; n < 2; ++n) acc[a][b][m][n] = (f32x4){0.f, 0.f, 0.f, 0.f};
        cur = nxt; cA = nA; cB = nB; ++ui;
        if constexpr (ALIGN_EPI) { if (wr == 1) PG8_BAR; }
    }
    PG8_WAIT_V(0);
    if constexpr (!ALIGN_EPI) { if (wr == 0) PG8_BAR; }
    PG8_BAR;
    if constexpr (Epi::AFTER_DRAIN) { E.fused(acc, cur, wr, wc, fr, fq, lds, wid, lane); S.done(cur); }
#undef PG8_SA
#undef PG8_SB
#undef PG8_STAGE
#undef PG8_LDA
#undef PG8_LDB
#undef PG8_MMA
#undef PG8_WAIT_V
#undef PG8_WAIT_L
#undef PG8_BAR
#undef PG8_SCHED
}
}
constexpr int NWAVES = 8, NTHREADS = NWAVES * 64;
constexpr int BATCH = 8, SEQ = 2048, D = 1024, M = BATCH * SEQ;
constexpr int DCONV = 512, DRWKV = 512, HEADS = 8, HD = 64;
constexpr int DIN = 3328;
constexpr int ZR = 1536, ZK = 2048, ZV = 2560, ZLO = 3072;
constexpr int NE = 32, NG = 4, EPG = 8, DE = 256;
constexpr int MAXSLOTS = 41216;
constexpr float RMS_EPS = 1e-6f, LN_X_EPS = 64e-5f;
#ifndef MK_N_LAUNCHES
#define MK_N_LAUNCHES 1
#endif
constexpr int NPHASES = 13;
constexpr size_t MiB = 1u << 20;
constexpr size_t WS_CTL = 0, CTL_ZERO_BYTES = 64 * 1024;
constexpr size_t WS_WRT = 1 * MiB;
constexpr size_t WS_TOK = 1 * MiB + 256 * 1024;
constexpr size_t WS_WIN = 4 * MiB, WS_WOUT = 2 * MiB;
constexpr size_t WS_XN = 12 * MiB;
constexpr size_t WS_ZC = 44 * MiB, WS_ZR = 92 * MiB, WS_Y = 148 * MiB;
constexpr int LDZC = 1536, LDZR = 1792;
constexpr size_t WS_LIN = 180 * MiB, WS_W3 = 188 * MiB;
constexpr size_t WS_AUX0 = 4 * MiB, WS_AUX1 = 20 * MiB, WS_AUX2 = 36 * MiB;
constexpr size_t WS_PHT = 52 * MiB, WS_PSI = 68 * MiB, WS_QQ = 190 * MiB, WS_PP = 206 * MiB, WS_G2 = 222 * MiB;
constexpr size_t WS_WGU = 92 * MiB, WS_WD = 124 * MiB, WS_XS = 4 * MiB, WS_HID = 221 * MiB, WS_SOUT = 140 * MiB, WS_END = 242 * MiB;
static_assert(WS_WOUT + (size_t)D * D * 2 <= WS_WIN && WS_WIN + (size_t)DIN * D * 2 <= WS_XN, "ws map");
static_assert(WS_XS + (size_t)MAXSLOTS * D * 2 <= WS_WGU && WS_SOUT + (size_t)MAXSLOTS * D * 2 <= WS_HID && WS_HID + (size_t)MAXSLOTS * DE * 2 <= WS_END && WS_WD + (size_t)NE * D * DE * 2 <= WS_SOUT, "ws map");
static_assert(WS_ZC + (size_t)M * LDZC * 2 <= WS_ZR && WS_ZR + (size_t)M * LDZR * 2 <= WS_Y && WS_Y + (size_t)M * D * 2 <= WS_LIN && WS_W3 + 1536 * 256 * 2 <= WS_QQ, "ws map");
constexpr int CW_TMO = 0, CW_BAR = 1024, CW_CNT = 8192;
constexpr int RING_BYTES = 131072, LDS_BYTES = 163840, MISC_OFF = LDS_BYTES - 2048, OFFS_OFF = MISC_OFF + 128, TILEE_OFF = MISC_OFF + 384;

#define GAS __attribute__((address_space(1)))
#define LAS __attribute__((address_space(3)))
typedef unsigned short bf16;
typedef unsigned v4u __attribute__((ext_vector_type(4)));
typedef unsigned v2u __attribute__((ext_vector_type(2)));
typedef float f32x4 __attribute__((ext_vector_type(4)));
typedef unsigned short us4 __attribute__((ext_vector_type(4)));
#define LDS_WAIT() asm volatile("s_waitcnt lgkmcnt(0)" ::: "memory")
typedef float f32x2_t __attribute__((ext_vector_type(2)));
typedef __bf16 bf16x2_t __attribute__((ext_vector_type(2)));
__device__ __forceinline__ unsigned pk2(float lo, float hi) { const f32x2_t v = {lo, hi}; const bf16x2_t b = __builtin_convertvector(v, bf16x2_t); return __builtin_bit_cast(unsigned, b); }
__device__ __forceinline__ unsigned f2bf(float f) { return pk2(f, 0.f) & 0xffffu; }
__device__ __forceinline__ float bf2f(unsigned short b) { return __builtin_bit_cast(float, (unsigned)b << 16); }
__device__ __forceinline__ float sigmoid_f(float x) { return 1.0f / (1.0f + __expf(-x)); }


#ifndef PROBE_ID
#define PROBE_ID -1
#endif
#define PT0_ (F.wave == 0 && __builtin_amdgcn_mbcnt_hi(~0u, __builtin_amdgcn_mbcnt_lo(~0u, 0u)) == 0u)
#define PB(id) do { if (PROBE_ID == (id) && PT0_) { *(volatile LAS unsigned long long*)(F.lds + MISC_OFF + 72) = __builtin_amdgcn_s_memrealtime(); } } while (0)
#define PE(id) do { if (PROBE_ID == (id) && PT0_) { volatile LAS unsigned long long* pp_ = (volatile LAS unsigned long long*)(F.lds + MISC_OFF + 64); pp_[0] = pp_[0] + (__builtin_amdgcn_s_memrealtime() - pp_[1]); } } while (0)
#define XB_TMO      128
#define XB_XCNT(j)  (256  + 64 * (j))
#define XB_XSUB(j)  (1280 + 64 * (j))
#define XB_XGEN(j)  (2304 + 64 * (j))
#define XB_TOP      3328
#define XB_TOPGEN   3392
#define XCD_BAR_WORDS 3456
#define XB_SPIN_CAP (1u << 18)
__device__ __forceinline__ unsigned xb_ld(unsigned* p)              { return __hip_atomic_load(p, __ATOMIC_RELAXED, __HIP_MEMORY_SCOPE_AGENT); }
__device__ __forceinline__ unsigned xb_add(unsigned* p, unsigned v) { return __hip_atomic_fetch_add(p, v, __ATOMIC_RELAXED, __HIP_MEMORY_SCOPE_AGENT); }
__device__ __forceinline__ unsigned xb_xcc_id() { return (unsigned)__builtin_amdgcn_s_getreg((3 << 11) | 20) & 0xFu; }
#define XB_SPIN(cond, bar) do { unsigned _sp = 0; while (cond) { __builtin_amdgcn_s_sleep(1); \
    if ((++_sp & 255u) == 0u) { if (xb_ld(&(bar)[XB_TMO])) break; if (_sp > XB_SPIN_CAP) { atomicAdd(&(bar)[XB_TMO], 1u); break; } } } } while (0)
struct XcdBarrier { unsigned* bar; unsigned x; volatile LAS unsigned* st; };
__device__ __forceinline__ XcdBarrier xcd_barrier_post(unsigned* bar, volatile LAS unsigned* st, bool t0) {
    XcdBarrier b; b.bar = bar; b.x = xb_xcc_id(); b.st = st;
    if (t0) (void)xb_add(&bar[XB_XCNT(b.x)], 1u);
    return b;
}
__device__ __forceinline__ void xcd_barrier_complete(unsigned* bar, unsigned x, unsigned& nloc, unsigned& nx) {
    const unsigned G = gridDim.x * gridDim.y * gridDim.z;
    unsigned sum, cnt, mine, sp = 0u;
    for (;;) {
        sum = 0u; cnt = 0u; mine = 0u;
#pragma unroll
        for (unsigned j = 0; j < 16; ++j) { const unsigned c = xb_ld(&bar[XB_XCNT(j)]); sum += c; cnt += (c > 0u) ? 1u : 0u; mine = (j == x) ? c : mine; }
        if (sum == G) break;
        __builtin_amdgcn_s_sleep(1);
        if ((++sp & 255u) == 0u) { if (xb_ld(&bar[XB_TMO])) break; if (sp > XB_SPIN_CAP) { atomicAdd(&bar[XB_TMO], 1u); break; } }
    }
    nloc = mine > 0u ? mine : 1u; nx = cnt > 0u ? cnt : 1u;
}
__device__ __forceinline__ void xcd_barrier(const XcdBarrier& b, bool t0) {
    asm volatile("s_waitcnt vmcnt(0)" ::: "memory");
    __syncthreads();
    if (t0) {
        unsigned* bar = b.bar;
        __builtin_amdgcn_s_waitcnt(0);
        unsigned nloc = b.st[0], nx = b.st[1];
        if (nloc == 0u) { xcd_barrier_complete(bar, b.x, nloc, nx); b.st[0] = nloc; b.st[1] = nx; }
        const unsigned old = xb_add(&bar[XB_XSUB(b.x)], 1u);
        const unsigned gen = old / nloc;
        if (old + 1u == (gen + 1u) * nloc) {
            __builtin_amdgcn_fence(__ATOMIC_RELEASE, "agent");
            asm volatile("s_waitcnt vmcnt(0)" ::: "memory");
            const unsigned og = xb_add(&bar[XB_TOP], 1u);
            const unsigned tg = og / nx;
            if (og + 1u == (tg + 1u) * nx) xb_add(&bar[XB_TOPGEN], 1u);
            else XB_SPIN(xb_ld(&bar[XB_TOPGEN]) == tg, bar);
            __builtin_amdgcn_fence(__ATOMIC_ACQUIRE, "agent");
            xb_add(&bar[XB_XGEN(b.x)], 1u);
            asm volatile("s_waitcnt vmcnt(0)" ::: "memory");
        } else {
            XB_SPIN(xb_ld(&bar[XB_XGEN(b.x)]) == gen, bar);
            __builtin_amdgcn_fence(__ATOMIC_ACQUIRE, "agent");
            asm volatile("s_waitcnt vmcnt(0)" ::: "memory");
        }
    }
    __syncthreads();
}

struct Args { const float* in[25]; float* out; unsigned char* ws; int ph_lo, ph_hi; };
struct Frame {
    LAS unsigned char* lds;
    int tid, lane, wave, G;
    unsigned* ctl;
};
enum InIdx { I_X = 0, I_G1, I_WIN, I_MU, I_CONVW, I_DECUP, I_DECBASE, I_AUP, I_ABASE, I_GUP, I_KK, I_KA, I_RK, I_LNW, I_LNB, I_WOUT, I_GFFN, I_RGW, I_RGB, I_REW, I_REB, I_EWG, I_EWU, I_EWD, I_GFIN };

__device__ __forceinline__ float wave_sum(float v) {
#pragma unroll
    for (int o = 1; o < 64; o <<= 1) v += __shfl_xor(v, o);
    return v;
}
__device__ __forceinline__ float sum16(float v) { v += __shfl_xor(v, 1); v += __shfl_xor(v, 2); v += __shfl_xor(v, 4); v += __shfl_xor(v, 8); return v; }
__device__ __forceinline__ float sum8(float v) { v += __shfl_xor(v, 1); v += __shfl_xor(v, 2); v += __shfl_xor(v, 4); return v; }

__device__ __forceinline__ void transpose_item(const float* W, int N, int k0, int n0, bf16* WT, int ldk, int drow0, LAS float* scr, int lane) {
    float tv[32];
#pragma unroll
    for (int i = 0; i < 32; ++i) tv[i] = W[(size_t)(k0 + 2 * i + (lane >> 5)) * N + n0 + (lane & 31)];
#pragma unroll
    for (int i = 0; i < 32; ++i) scr[(2 * i + (lane >> 5)) * 33 + (lane & 31)] = tv[i];
    LDS_WAIT(); asm volatile("" ::: "memory");
    const int c = lane & 7;
#pragma unroll
    for (int j = 0; j < 4; ++j) { const int n = (lane >> 3) + 8 * j; const LAS float* s = scr + (8 * c) * 33 + n;
        v4u o; o.x = pk2(s[0 * 33], s[1 * 33]); o.y = pk2(s[2 * 33], s[3 * 33]); o.z = pk2(s[4 * 33], s[5 * 33]); o.w = pk2(s[6 * 33], s[7 * 33]);
        *(v4u*)(WT + (size_t)(drow0 + n) * ldk + k0 + 8 * c) = o; }
    LDS_WAIT(); asm volatile("" ::: "memory");
}

__device__ __forceinline__ void p0_prologue(const Frame& F, const Args& A) {
    LAS float* scr = (LAS float*)(F.lds + F.wave * 16384);
    const int gw = blockIdx.x * NWAVES + F.wave, NGW = F.G * NWAVES;
    bf16* WinT = (bf16*)(A.ws + WS_WIN); bf16* WoutT = (bf16*)(A.ws + WS_WOUT);
    constexpr int I_IN = (D / 64) * (DIN / 32), I_OUT = (D / 64) * (D / 32);
    for (int it = gw; it < I_IN + I_OUT; it += NGW) {
        if (it < I_IN) { const int kb = it / (DIN / 32), nb = it % (DIN / 32); transpose_item(A.in[I_WIN], DIN, 64 * kb, 32 * nb, WinT, D, 32 * nb, scr, F.lane); }
        else { const int r = it - I_IN, kb = r / (D / 32), nb = r % (D / 32); transpose_item(A.in[I_WOUT], D, 64 * kb, 32 * nb, WoutT, D, 32 * nb, scr, F.lane); }
    }
    { float* WrT = (float*)(A.ws + WS_WRT);
      for (int i = blockIdx.x * NTHREADS + F.tid; i < 36 * D; i += F.G * NTHREADS) { const int n = i / D, k = i % D;
          WrT[i] = (n < NG) ? A.in[I_RGW][k * NG + n] : A.in[I_REW][k * NE + (n - NG)]; } }
    { bf16* W3T = (bf16*)(A.ws + WS_W3);
      for (int i = blockIdx.x * NTHREADS + F.tid; i < 256 * 1536; i += F.G * NTHREADS) { const int k = i / 1536, n = i % 1536; float v = 0.f;
          if (n < 512) { if (k < 64) v = A.in[I_DECUP][k * 512 + n]; }
          else if (n < 1024) { if (k >= 64 && k < 128) v = A.in[I_AUP][(k - 64) * 512 + (n - 512)]; }
          else { if (k >= 128) v = A.in[I_GUP][(k - 128) * 512 + (n - 1024)]; }
          W3T[(size_t)n * 256 + k] = (bf16)f2bf(v); } }
    bf16* XN = (bf16*)(A.ws + WS_XN);
    const f32x4* g4 = (const f32x4*)A.in[I_G1] + F.lane;
    for (int m = gw; m < M; m += NGW) {
        const f32x4* xr = (const f32x4*)(A.in[I_X] + (size_t)m * D) + F.lane;
        f32x4 v[4]; float s = 0.f;
#pragma unroll
        for (int j = 0; j < 4; ++j) { v[j] = xr[64 * j]; s += (v[j].x * v[j].x + v[j].y * v[j].y) + (v[j].z * v[j].z + v[j].w * v[j].w); }
        const float rs = rsqrtf(wave_sum(s) * (1.f / D) + RMS_EPS);
        v2u* o8 = (v2u*)(XN + (size_t)m * D) + F.lane;
#pragma unroll
        for (int j = 0; j < 4; ++j) { const f32x4 g = g4[64 * j]; v2u o; o.x = pk2(v[j].x * rs * g.x, v[j].y * rs * g.y); o.y = pk2(v[j].z * rs * g.z, v[j].w * rs * g.w); o8[64 * j] = o; }
    }
}

__device__ __forceinline__ float bflo(unsigned w) { return __builtin_bit_cast(float, w << 16); }
__device__ __forceinline__ float bfhi(unsigned w) { return __builtin_bit_cast(float, w & 0xffff0000u); }
__device__ __forceinline__ void p2a_mix(const Frame& F, const Args& A) {
    const bf16* ZC = (const bf16*)(A.ws + WS_ZC); const bf16* ZR = (const bf16*)(A.ws + WS_ZR); bf16* Y = (bf16*)(A.ws + WS_Y); bf16* LIN = (bf16*)(A.ws + WS_LIN);
    for (int it = blockIdx.x; it < M / 64; it += F.G) {
        const int m0 = it * 64;
        {
            const int c8 = (F.tid & 63) * 8, r0 = m0 + (F.tid >> 6) * 8, ts = r0 % SEQ;
            float w0[8], w1[8], w2[8];
#pragma unroll
            for (int q = 0; q < 8; ++q) { w0[q] = A.in[I_CONVW][c8 + q]; w1[q] = A.in[I_CONVW][512 + c8 + q]; w2[q] = A.in[I_CONVW][1024 + c8 + q]; }
            float ch2[8], ch1[8];
#pragma unroll
            for (int q = 0; q < 8; ++q) { ch2[q] = 0.f; ch1[q] = 0.f; }
            if (ts != 0) {
                const v4u c2 = *(const v4u*)(ZC + (size_t)(r0 - 2) * LDZC + 512 + c8), h2 = *(const v4u*)(ZC + (size_t)(r0 - 2) * LDZC + 1024 + c8);
                const v4u c1 = *(const v4u*)(ZC + (size_t)(r0 - 1) * LDZC + 512 + c8), h1 = *(const v4u*)(ZC + (size_t)(r0 - 1) * LDZC + 1024 + c8);
#pragma unroll
                for (int q = 0; q < 4; ++q) { ch2[2 * q] = bflo(c2[q]) * bflo(h2[q]); ch2[2 * q + 1] = bfhi(c2[q]) * bfhi(h2[q]); ch1[2 * q] = bflo(c1[q]) * bflo(h1[q]); ch1[2 * q + 1] = bfhi(c1[q]) * bfhi(h1[q]); }
            }
#pragma unroll
            for (int i = 0; i < 8; ++i) {
                const bf16* zr = ZC + (size_t)(r0 + i) * LDZC;
                const v4u bg = *(const v4u*)(zr + c8), cg = *(const v4u*)(zr + 512 + c8), hh = *(const v4u*)(zr + 1024 + c8);
                float y[8];
#pragma unroll
                for (int q = 0; q < 4; ++q) {
                    const float ca = bflo(cg[q]) * bflo(hh[q]), cb = bfhi(cg[q]) * bfhi(hh[q]);
                    y[2 * q] = bflo(bg[q]) * (w0[2 * q] * ch2[2 * q] + w1[2 * q] * ch1[2 * q] + w2[2 * q] * ca);
                    y[2 * q + 1] = bfhi(bg[q]) * (w0[2 * q + 1] * ch2[2 * q + 1] + w1[2 * q + 1] * ch1[2 * q + 1] + w2[2 * q + 1] * cb);
                    ch2[2 * q] = ch1[2 * q]; ch1[2 * q] = ca; ch2[2 * q + 1] = ch1[2 * q + 1]; ch1[2 * q + 1] = cb; }
                v4u o; o.x = pk2(y[0], y[1]); o.y = pk2(y[2], y[3]); o.z = pk2(y[4], y[5]); o.w = pk2(y[6], y[7]);
                *(v4u*)(Y + (size_t)(r0 + i) * D + c8) = o;
            }
        }
        {
            const int j8 = (F.tid & 31) * 8; float mu[8];
#pragma unroll
            for (int q = 0; q < 8; ++q) mu[q] = A.in[I_MU][1536 + j8 + q];
#pragma unroll
            for (int i = 0; i < 4; ++i) {
                const int m = m0 + (F.tid >> 5) + 16 * i;
                const v4u zc = *(const v4u*)(ZR + (size_t)m * LDZR + 1536 + j8); v4u zp = {0u, 0u, 0u, 0u};
                if ((m % SEQ) > 0) zp = *(const v4u*)(ZR + (size_t)(m - 1) * LDZR + 1536 + j8);
                float f[8];
#pragma unroll
                for (int q = 0; q < 4; ++q) { const float a = bflo(zc[q]), b = bfhi(zc[q]); f[2 * q] = a + (bflo(zp[q]) - a) * mu[2 * q]; f[2 * q + 1] = b + (bfhi(zp[q]) - b) * mu[2 * q + 1]; }
                if (j8 < 64) {
#pragma unroll
                    for (int q = 0; q < 8; ++q) f[q] = tanhf(f[q]); }
                else if (j8 >= 128) {
#pragma unroll
                    for (int q = 0; q < 8; ++q) f[q] = sigmoid_f(f[q]); }
                v4u o; o.x = pk2(f[0], f[1]); o.y = pk2(f[2], f[3]); o.z = pk2(f[4], f[5]); o.w = pk2(f[6], f[7]);
                *(v4u*)(LIN + (size_t)m * 256 + j8) = o;
            }
        }
    }
}
template <int CTRL> __device__ __forceinline__ float dpp_f(float x) { return __builtin_bit_cast(float, __builtin_amdgcn_update_dpp(0, __builtin_bit_cast(int, x), CTRL, 0xF, 0xF, true)); }
__device__ __forceinline__ float dsum8(float v) { v += dpp_f<0xB1>(v); v += dpp_f<0x4E>(v); v += dpp_f<0x141>(v); return v; }
__device__ __forceinline__ float dsum16(float v) { v = dsum8(v); v += dpp_f<0x140>(v); return v; }
typedef short bf16x8_t __attribute__((ext_vector_type(8)));
constexpr int LDP = 72;
constexpr int LDF = 68;
constexpr int PA_TS = 0;
constexpr int PA_B0 = 65536, PA_BSZ = 64 * LDP * 2;
constexpr int PA_GC = PA_B0 + 10 * PA_BSZ, PA_BON = PA_GC + 256, PA_END = PA_BON + 256;
static_assert(PA_END <= MISC_OFF, "phase A LDS map");
#define PA_BUF(i) (PA_B0 + (i) * PA_BSZ)
__device__ __forceinline__ bf16x8_t ld8(const LAS bf16* p) { return *(const LAS bf16x8_t*)p; }
__device__ __forceinline__ bf16x8_t ld8(const bf16* p) { return *(const bf16x8_t*)p; }
struct MmPos { int rb, cb, fr, fq; };
template <int K, bool SWAP, typename PX, typename PY>
__device__ __forceinline__ void mm_nt(PX X, int ldx, PY Yt, int ldy, const MmPos& p, f32x4 (&acc)[2]) {
    const unsigned xo = (unsigned)((p.rb * 16 + p.fr) * ldx + p.fq * 8), yo = (unsigned)((p.cb + p.fr) * ldy + p.fq * 8);
#pragma unroll
    for (int ks = 0; ks < K / 32; ++ks) {
        const bf16x8_t a = ld8(X + (xo + ks * 32));
#pragma unroll
        for (int n = 0; n < 2; ++n) { const bf16x8_t b = ld8(Yt + (yo + (unsigned)(n * 16 * ldy + ks * 32)));
            acc[n] = SWAP ? __builtin_amdgcn_mfma_f32_16x16x32_bf16(b, a, acc[n], 0, 0, 0) : __builtin_amdgcn_mfma_f32_16x16x32_bf16(a, b, acc[n], 0, 0, 0); }
    }
}
__device__ __forceinline__ v2u pack4(const f32x4& v) { v2u o; o.x = pk2(v.x, v.y); o.y = pk2(v.z, v.w); return o; }
__device__ __forceinline__ void zero2(f32x4 (&a)[2]) { a[0] = (f32x4){0.f, 0.f, 0.f, 0.f}; a[1] = a[0]; }
#define PA_SYNC() __syncthreads()

constexpr int PA_WTOT = PA_BON + 256;
static_assert(PA_WTOT + 2048 <= MISC_OFF, "phase A LDS map");
struct HeadIn { unsigned short rz[9], kz[9], vz[9], lam[8], aa[8]; float cst[6]; };
__device__ __forceinline__ void pa_load(HeadIn& in, const Args& A, int m0, int h, int t8, int c, bool halo) {
    asm volatile("" : "+s"(t8));
    const bf16* ZR = (const bf16*)(A.ws + WS_ZR); const bf16* LAM = (const bf16*)(A.ws + WS_AUX0); const bf16* AAg = (const bf16*)(A.ws + WS_AUX1);
    const int hcc = h * HD + c;
    const bf16* zb = ZR + ((size_t)(m0 + t8) - 1) * LDZR + hcc;
    in.rz[0] = halo ? zb[0] : (unsigned short)0; in.kz[0] = halo ? zb[512] : (unsigned short)0; in.vz[0] = halo ? zb[1024] : (unsigned short)0;
#pragma unroll
    for (int j = 1; j < 9; ++j) { in.rz[j] = zb[(size_t)j * LDZR]; in.kz[j] = zb[(size_t)j * LDZR + 512]; in.vz[j] = zb[(size_t)j * LDZR + 1024]; }
#pragma unroll
    for (int i = 0; i < 8; ++i) { in.lam[i] = LAM[(size_t)(m0 + t8 + i) * 512 + hcc]; in.aa[i] = AAg[(size_t)(m0 + t8 + i) * 512 + hcc]; }
    in.cst[0] = A.in[I_MU][hcc]; in.cst[1] = A.in[I_MU][512 + hcc]; in.cst[2] = A.in[I_MU][1024 + hcc]; in.cst[3] = A.in[I_KK][hcc]; in.cst[4] = A.in[I_KA][hcc]; in.cst[5] = A.in[I_RK][hcc];
}
template <bool FULL>
__device__ __forceinline__ void pa_prep(const Frame& F, const HeadIn& in, int c, int t8) {
    LAS unsigned char* L = F.lds;
    LAS float* WTOT = (LAS float*)(L + PA_WTOT);
    float l[8];
    l[0] = bf2f(in.lam[0]);
#pragma unroll
    for (int i = 1; i < 8; ++i) l[i] = l[i - 1] + bf2f(in.lam[i]);
    WTOT[F.wave * 64 + c] = l[7];
    PA_SYNC();
    float off = 0.f;
#pragma unroll
    for (int w = 0; w < 7; ++w) off += (w < F.wave) ? WTOT[w * 64 + c] : 0.f;
    const float mur = in.cst[0], muk = in.cst[1], muv = in.cst[2], ckk = in.cst[3], cka = in.cst[4], crk = in.cst[5];
    LAS bf16* KAP = (LAS bf16*)(L + PA_BUF(0)); LAS bf16* BH = (LAS bf16*)(L + PA_BUF(1)); LAS bf16* KH = (LAS bf16*)(L + PA_BUF(2)); LAS bf16* RH = (LAS bf16*)(L + PA_BUF(3));
    float bh8[8], kh8[8], v8[8], kap8[8];
#pragma unroll
    for (int i = 0; i < 8; ++i) {
        const int t = t8 + i; const float aq = bf2f(in.aa[i]);
        const float r0 = bf2f(in.rz[i + 1]), k0 = bf2f(in.kz[i + 1]), v0 = bf2f(in.vz[i + 1]);
        const float rr = r0 + (bf2f(in.rz[i]) - r0) * mur, kk = k0 + (bf2f(in.kz[i]) - k0) * muk, vv = v0 + (bf2f(in.vz[i]) - v0) * muv;
        const float kkn = kk * ckk, kpm = kk * (1.0f + (aq - 1.0f) * cka);
        float ss = dsum16(kkn * kkn), bd = 0.f;
        ss += __shfl_xor(ss, 16); ss += __shfl_xor(ss, 32);
        if (FULL) { bd = dsum16(rr * kpm * crk); bd += __shfl_xor(bd, 16); bd += __shfl_xor(bd, 32); }
        const float lgt = off + l[i], lgp = (i > 0) ? off + l[i - 1] : off;
        const float kkq = kkn * __builtin_amdgcn_rsqf(fmaxf(ss, 1e-24f)), gi = __expf(lgt);
        const float kapv = __expf(-lgp) * kkq, bhv = kkq * aq * gi, khv = kpm * gi, rhv = __expf(-lgt) * rr;
        v8[i] = vv; kap8[i] = kapv; bh8[i] = bhv; kh8[i] = khv;
        KAP[t * LDP + c] = (bf16)f2bf(kapv); BH[t * LDP + c] = (bf16)f2bf(bhv);
        if (FULL) { KH[t * LDP + c] = (bf16)f2bf(khv); RH[t * LDP + c] = (bf16)f2bf(rhv); if (c == 0) ((LAS float*)(L + PA_BON))[t] = bd; }
    }
    if (FULL) {
        LAS bf16* BHT = (LAS bf16*)(L + PA_BUF(4)); LAS bf16* KHT = (LAS bf16*)(L + PA_BUF(5)); LAS bf16* VT = (LAS bf16*)(L + PA_BUF(6)); LAS bf16* KAPT = (LAS bf16*)(L + PA_BUF(7));
        { v4u o; o.x = pk2(bh8[0], bh8[1]); o.y = pk2(bh8[2], bh8[3]); o.z = pk2(bh8[4], bh8[5]); o.w = pk2(bh8[6], bh8[7]); *(LAS v4u*)(BHT + c * LDP + t8) = o; }
        { v4u o; o.x = pk2(kh8[0], kh8[1]); o.y = pk2(kh8[2], kh8[3]); o.z = pk2(kh8[4], kh8[5]); o.w = pk2(kh8[6], kh8[7]); *(LAS v4u*)(KHT + c * LDP + t8) = o; }
        { v4u o; o.x = pk2(v8[0], v8[1]); o.y = pk2(v8[2], v8[3]); o.z = pk2(v8[4], v8[5]); o.w = pk2(v8[6], v8[7]); *(LAS v4u*)(VT + c * LDP + t8) = o; }
        { v4u o; o.x = pk2(kap8[0], kap8[1]); o.y = pk2(kap8[2], kap8[3]); o.z = pk2(kap8[4], kap8[5]); o.w = pk2(kap8[6], kap8[7]); *(LAS v4u*)(KAPT + c * LDP + t8) = o; }
        if (F.wave == 7) ((LAS float*)(L + PA_GC))[c] = __expf(-(off + l[7]));
    }
}

template <int T0> __device__ __forceinline__ void pa_solve_row(const LAS bf16* Ts, int lane, float (&X)[64]) {
    int lv = lane; asm volatile("" : "+v"(lv));
    float acc = (lv == T0) ? 1.f : 0.f;
#pragma clang loop unroll(full)
    for (int i8 = 0; i8 < (T0 + 7) / 8; ++i8) {
        const v4u raw = *(const LAS v4u*)(Ts + T0 * 64 + i8 * 8);
#pragma clang loop unroll(full)
        for (int e = 0; e < 8; ++e) { const int i = i8 * 8 + e; if (i < T0) { const unsigned w = raw[e >> 1]; acc -= ((e & 1) ? bfhi(w) : bflo(w)) * X[i]; } }
    }
    X[T0] = acc;
    asm volatile("" ::: "memory");
}
template <int T0> struct PaSolveRows { static __device__ __forceinline__ void run(const LAS bf16* Ts, int lane, float (&X)[64]) { PaSolveRows<T0 - 1>::run(Ts, lane, X); pa_solve_row<T0>(Ts, lane, X); } };
template <> struct PaSolveRows<-1> { static __device__ __forceinline__ void run(const LAS bf16*, int, float (&)[64]) {} };
__device__ __forceinline__ void pa_solve_T(LAS bf16* Ts, int lane) {
    float X[64];
    PaSolveRows<63>::run(Ts, lane, X);
#pragma clang loop unroll(full)
    for (int t = 0; t < 64; ++t) Ts[t * 64 + lane] = (bf16)f2bf(X[t]);
}

__device__ __forceinline__ void pa_step1(const Frame& F, const HeadIn& in, int h, int c, int t8, const MmPos& p) {
    asm volatile("" : "+s"(t8));
    LAS unsigned char* L = F.lds;
    PB(3); pa_prep<false>(F, in, c, t8); PA_SYNC(); PE(3);
    PB(4);
    f32x4 ab[2]; zero2(ab);
    mm_nt<64, true>((const LAS bf16*)(L + PA_BUF(0)), LDP, (const LAS bf16*)(L + PA_BUF(1)), LDP, p, ab);
    LAS bf16* Ts = (LAS bf16*)(L + PA_TS + h * 8192);
#pragma unroll
    for (int n = 0; n < 2; ++n) { const int t = p.rb * 16 + p.fr, j0 = p.cb + n * 16 + 4 * p.fq; f32x4 v = ab[n];
#pragma unroll
        for (int i = 0; i < 4; ++i) v[i] = (j0 + i < t) ? v[i] : 0.f;
        *(LAS v2u*)(Ts + t * 64 + j0) = pack4(v); }
    PA_SYNC();
    PE(4);
}
__device__ __forceinline__ void pa_step2(const Frame& F, const Args& A, const HeadIn& in, int item, int h, int c, int t8, const MmPos& p) {
    asm volatile("" : "+s"(t8));
    LAS unsigned char* L = F.lds;
    bf16* PHT = (bf16*)(A.ws + WS_PHT); bf16* PSI = (bf16*)(A.ws + WS_PSI); bf16* QQ = (bf16*)(A.ws + WS_QQ); bf16* PP = (bf16*)(A.ws + WS_PP); bf16* G2 = (bf16*)(A.ws + WS_G2);
    const size_t ch = ((size_t)item * HEADS + h) * 4096;
    PB(3); pa_prep<true>(F, in, c, t8); PA_SYNC(); PE(3);
    PB(6);
    const LAS bf16* KAP = (const LAS bf16*)(L + PA_BUF(0)); const LAS bf16* BH = (const LAS bf16*)(L + PA_BUF(1)); const LAS bf16* KH = (const LAS bf16*)(L + PA_BUF(2)); const LAS bf16* RH = (const LAS bf16*)(L + PA_BUF(3));
    const LAS bf16* BHT = (const LAS bf16*)(L + PA_BUF(4)); const LAS bf16* KHT = (const LAS bf16*)(L + PA_BUF(5)); const LAS bf16* VT = (const LAS bf16*)(L + PA_BUF(6)); const LAS bf16* KAPT = (const LAS bf16*)(L + PA_BUF(7));
    LAS bf16* ARB = (LAS bf16*)(L + PA_BUF(8)); LAS bf16* ARK = (LAS bf16*)(L + PA_BUF(9));
    LAS bf16* AK = (LAS bf16*)(L + PA_BUF(0)); LAS bf16* YT = (LAS bf16*)(L + PA_BUF(1)); LAS bf16* WT = (LAS bf16*)(L + PA_BUF(2)); LAS bf16* UT = (LAS bf16*)(L + PA_BUF(0));
    const LAS bf16* Ts = (const LAS bf16*)(L + PA_TS + h * 8192);
    const int tt = p.rb * 16 + p.fr;
    {
        f32x4 arb[2], ark[2], ak[2]; zero2(arb); zero2(ark); zero2(ak);
        mm_nt<64, true>(RH, LDP, BH, LDP, p, arb); mm_nt<64, true>(RH, LDP, KH, LDP, p, ark); mm_nt<64, true>(KAP, LDP, KH, LDP, p, ak);
#pragma unroll
        for (int n = 0; n < 2; ++n) { const int j0 = p.cb + n * 16 + 4 * p.fq;
#pragma unroll
            for (int i = 0; i < 4; ++i) { const bool le = (j0 + i <= tt), lt = (j0 + i < tt); arb[n][i] = le ? arb[n][i] : 0.f; ark[n][i] = le ? ark[n][i] : 0.f; ak[n][i] = lt ? ak[n][i] : 0.f; }
            *(LAS v2u*)(ARB + tt * LDP + j0) = pack4(arb[n]); *(LAS v2u*)(ARK + tt * LDP + j0) = pack4(ark[n]); }
        PA_SYNC();
#pragma unroll
        for (int n = 0; n < 2; ++n) *(LAS v2u*)(AK + tt * LDP + p.cb + n * 16 + 4 * p.fq) = pack4(ak[n]);
    }
    PA_SYNC();
    PE(6); PB(7);
    {
        f32x4 y[2]; zero2(y);
        mm_nt<64, false>((const LAS bf16*)AK, LDP, VT, LDP, p, y);
#pragma unroll
        for (int n = 0; n < 2; ++n) *(LAS v2u*)(YT + (p.cb + n * 16 + p.fr) * LDP + p.rb * 16 + 4 * p.fq) = pack4(y[n]);
    }
    PA_SYNC();
    {
        f32x4 w[2], u[2]; zero2(w); zero2(u);
        mm_nt<64, false>(Ts, 64, KAPT, LDP, p, w); mm_nt<64, false>(Ts, 64, (const LAS bf16*)YT, LDP, p, u);
#pragma unroll
        for (int n = 0; n < 2; ++n) { *(LAS v2u*)(WT + (p.cb + n * 16 + p.fr) * LDP + p.rb * 16 + 4 * p.fq) = pack4(w[n]); *(LAS v2u*)(UT + (p.cb + n * 16 + p.fr) * LDP + p.rb * 16 + 4 * p.fq) = pack4(u[n]); }
    }
    PA_SYNC();
    PE(7); PB(8);
    {
        f32x4 q[2], pa[2], pb[2]; zero2(q); zero2(pa); zero2(pb);
        mm_nt<64, true>((const LAS bf16*)ARB, LDP, (const LAS bf16*)WT, LDP, p, q); mm_nt<64, true>((const LAS bf16*)ARK, LDP, VT, LDP, p, pa); mm_nt<64, true>((const LAS bf16*)ARB, LDP, (const LAS bf16*)UT, LDP, p, pb);
#pragma unroll
        for (int n = 0; n < 2; ++n) { const int c0 = p.cb + n * 16 + 4 * p.fq; const v2u rw = *(const LAS v2u*)(RH + tt * LDP + c0);
            f32x4 qv; qv.x = bflo(rw.x) - q[n].x; qv.y = bfhi(rw.x) - q[n].y; qv.z = bflo(rw.y) - q[n].z; qv.w = bfhi(rw.y) - q[n].w;
            *(v2u*)(QQ + ch + ((p.rb * 2 + (p.cb >> 5)) * 64 + (n * 2 + (p.fq >> 1)) * 16 + p.fr) * 8 + 4 * (p.fq & 1)) = pack4(qv);
            *(v2u*)(PP + ch + ((p.rb * 4 + (p.cb >> 4) + n) * 64 + p.fq * 16 + p.fr) * 4) = pack4(pa[n] - pb[n]); }
    }
    {
        f32x4 cc[2]; zero2(cc);
        mm_nt<64, false>((const LAS bf16*)WT, LDP, BHT, LDP, p, cc);
#pragma unroll
        for (int n = 0; n < 2; ++n) { const int k2 = p.cb + n * 16 + p.fr, k1 = p.rb * 16 + 4 * p.fq; const float gc = ((const LAS float*)(L + PA_GC))[k2]; f32x4 v;
#pragma unroll
            for (int i = 0; i < 4; ++i) v[i] = (((k1 + i) == k2 ? 1.f : 0.f) - cc[n][i]) * gc;
            *(v2u*)(PHT + ch + (((k2 >> 4) * 2 + (k1 >> 5)) * 64 + ((k1 & 31) >> 3) * 16 + (k2 & 15)) * 8 + (k1 & 7)) = pack4(v); }
    }
    {
        f32x4 sa[2], sb[2]; zero2(sa); zero2(sb);
        mm_nt<64, true>(VT, LDP, KHT, LDP, p, sa); mm_nt<64, true>((const LAS bf16*)UT, LDP, BHT, LDP, p, sb);
#pragma unroll
        for (int n = 0; n < 2; ++n) { const int k0 = p.cb + n * 16 + 4 * p.fq; const f32x4 gc = *(const LAS f32x4*)((const LAS float*)(L + PA_GC) + k0);
            *(v2u*)(PSI + ch + ((p.rb * 4 + (p.cb >> 4) + n) * 64 + p.fq * 16 + p.fr) * 4) = pack4((sa[n] - sb[n]) * gc); }
    }
    {
        const float bon = ((const LAS float*)(L + PA_BON))[tt];
#pragma unroll
        for (int n = 0; n < 2; ++n) { const int v0 = p.cb + n * 16 + 4 * p.fq; const f32x4 lb = *(const f32x4*)(A.in[I_LNB] + h * HD + v0);
            f32x4 vv;
#pragma unroll
            for (int i = 0; i < 4; ++i) vv[i] = bf2f(VT[(v0 + i) * LDP + tt]);
            *(v2u*)(G2 + ch + ((p.rb * 4 + (p.cb >> 4) + n) * 64 + p.fq * 16 + p.fr) * 4) = pack4(lb + bon * vv); }
    }
    PA_SYNC();
    PE(8);
}
__device__ __forceinline__ void pa_phase(const Frame& F, const Args& A) {
    LAS unsigned char* L = F.lds;
    for (int item = blockIdx.x; item < BATCH * (SEQ / 64); item += F.G) {
        const int b = item / (SEQ / 64), chunk = item % (SEQ / 64), m0 = b * SEQ + chunk * 64;
        int tidv = F.tid; asm volatile("" : "+v"(tidv));
        const int c = tidv & 63, t8 = F.wave * 8; const bool halo = chunk > 0 || t8 > 0;
        MmPos p; p.rb = F.wave >> 1; p.cb = (F.wave & 1) * 32; p.fr = tidv & 15; p.fq = (tidv >> 4) & 3;
        HeadIn cur, nxt;
        pa_load(cur, A, m0, 0, t8, c, halo);
#pragma unroll 1
        for (int h = 0; h < HEADS; ++h) {
            pa_load(nxt, A, m0, (h + 1) & 7, t8, c, halo);
            pa_step1(F, cur, h, c, t8, p);
            cur = nxt;
        }
        PB(5);
        { int lanev = F.lane; asm volatile("" : "+v"(lanev)); pa_solve_T((LAS bf16*)(L + PA_TS + F.wave * 8192), lanev); }
        PA_SYNC();
        PE(5);
#pragma unroll 1
        for (int h = 0; h < HEADS; ++h) {
            pa_load(nxt, A, m0, (h + 1) & 7, t8, c, halo);
            pa_step2(F, A, cur, item, h, c, t8, p);
            cur = nxt;
        }
    }
}

struct ScanOps { bf16x8_t b[4][2]; v2u psi[4]; };
__device__ __forceinline__ void ps_load(ScanOps& o, const bf16* PHT, const bf16* PSI, size_t ch, int tt, int fr, int fq) {
#pragma unroll
    for (int n = 0; n < 4; ++n) { o.psi[n] = *(const v2u*)(PSI + ch + (((tt >> 4) * 4 + n) * 64 + fq * 16 + fr) * 4);
#pragma unroll
        for (int ks = 0; ks < 2; ++ks) o.b[n][ks] = *(const bf16x8_t*)(PHT + ch + ((n * 2 + ks) * 64 + fq * 16 + fr) * 8); }
}
__device__ __forceinline__ void ps_scan(const Frame& F, const Args& A, int item) {
    LAS unsigned char* L = F.lds;
    const int fr = F.lane & 15, fq = F.lane >> 4, tt = (F.wave & 3) * 16 + fr;
    const bf16* PHT = (const bf16*)(A.ws + WS_PHT); const bf16* PSI = (const bf16*)(A.ws + WS_PSI); bf16* SST = (bf16*)A.out;
    const int b = item >> 3, h = item & 7;
    const size_t ch0 = ((size_t)(b * (SEQ / 64)) * HEADS + h) * 4096, cstep = (size_t)HEADS * 4096;
    if (F.wave < 4) {
        f32x4 s[4];
#pragma unroll
        for (int n = 0; n < 4; ++n) s[n] = (f32x4){0.f, 0.f, 0.f, 0.f};
        ScanOps oa, ob;
        ps_load(oa, PHT, PSI, ch0, tt, fr, fq);
#pragma unroll 1
        for (int c = 0; c < SEQ / 64; c += 2) {
#pragma unroll
            for (int u = 0; u < 2; ++u) {
                ScanOps& cur = u ? ob : oa; ScanOps& nxt = u ? oa : ob;
                const int cn = (c + u + 1 < SEQ / 64) ? c + u + 1 : c + u;
                ps_load(nxt, PHT, PSI, ch0 + (size_t)cn * cstep, tt, fr, fq);
                LAS bf16* SB = (LAS bf16*)(L + u * PA_BSZ);
#pragma unroll
                for (int n = 0; n < 4; ++n) *(LAS v2u*)(SB + tt * LDP + n * 16 + 4 * fq) = pack4(s[n]);
                asm volatile("s_waitcnt lgkmcnt(0)" ::: "memory"); __builtin_amdgcn_s_barrier(); asm volatile("" ::: "memory");
                f32x4 acc[4];
#pragma unroll
                for (int n = 0; n < 4; ++n) acc[n] = (f32x4){0.f, 0.f, 0.f, 0.f};
#pragma unroll
                for (int ks = 0; ks < 2; ++ks) { const bf16x8_t a = *(const LAS bf16x8_t*)(SB + tt * LDP + ks * 32 + fq * 8);
#pragma unroll
                    for (int n = 0; n < 4; ++n) acc[n] = __builtin_amdgcn_mfma_f32_16x16x32_bf16(cur.b[n][ks], a, acc[n], 0, 0, 0); }
#pragma unroll
                for (int n = 0; n < 4; ++n) { s[n].x = acc[n].x + bflo(cur.psi[n].x); s[n].y = acc[n].y + bfhi(cur.psi[n].x); s[n].z = acc[n].z + bflo(cur.psi[n].y); s[n].w = acc[n].w + bfhi(cur.psi[n].y); }
            }
        }
    } else {
        const int w4 = F.wave - 4;
#pragma unroll 1
        for (int c = 0; c < SEQ / 64; ++c) {
            const LAS bf16* SB = (const LAS bf16*)(L + (c & 1) * PA_BSZ);
            asm volatile("s_waitcnt lgkmcnt(0)" ::: "memory"); __builtin_amdgcn_s_barrier(); asm volatile("" ::: "memory");
            const v4u x0 = *(const LAS v4u*)(SB + (w4 * 16 + fr) * LDP + fq * 8), x1 = *(const LAS v4u*)(SB + (w4 * 16 + fr) * LDP + 32 + fq * 8);
            bf16* dst = SST + ch0 + (size_t)c * cstep + ((w4 * 2) * 64 + fq * 16 + fr) * 8;
            *(v4u*)dst = x0; *(v4u*)(dst + 512) = x1;
        }
    }
}

__device__ __forceinline__ void pc_phase(const Frame& F, const Args& A) {
    const bf16* QQ = (const bf16*)(A.ws + WS_QQ); const bf16* PP = (const bf16*)(A.ws + WS_PP); const bf16* GG = (const bf16*)(A.ws + WS_AUX2); const bf16* G2 = (const bf16*)(A.ws + WS_G2);
    const bf16* SST = (const bf16*)A.out; bf16* Y = (bf16*)(A.ws + WS_Y);
    const int fr = F.lane & 15, fq = F.lane >> 4, rbk = F.wave & 3;
    for (int item = blockIdx.x; item < BATCH * (SEQ / 64); item += F.G) {
        const int b = item / (SEQ / 64), chunk = item % (SEQ / 64), m0 = b * SEQ + chunk * 64, tt = rbk * 16 + fr;
#pragma unroll 1
        for (int hp = 0; hp < 4; ++hp) {
            const int h = hp * 2 + (F.wave >> 2); const size_t ch = ((size_t)item * HEADS + h) * 4096;
            f32x4 o[4];
#pragma unroll
            for (int n = 0; n < 4; ++n) o[n] = (f32x4){0.f, 0.f, 0.f, 0.f};
#pragma unroll
            for (int ks = 0; ks < 2; ++ks) { const bf16x8_t a = *(const bf16x8_t*)(QQ + ch + ((rbk * 2 + ks) * 64 + fq * 16 + fr) * 8);
#pragma unroll
                for (int n = 0; n < 4; ++n) { const bf16x8_t bb = *(const bf16x8_t*)(SST + ch + ((n * 2 + ks) * 64 + fq * 16 + fr) * 8); o[n] = __builtin_amdgcn_mfma_f32_16x16x32_bf16(bb, a, o[n], 0, 0, 0); } }
            float sum = 0.f;
#pragma unroll
            for (int n = 0; n < 4; ++n) { const v2u pw = *(const v2u*)(PP + ch + ((rbk * 4 + n) * 64 + fq * 16 + fr) * 4); o[n].x += bflo(pw.x); o[n].y += bfhi(pw.x); o[n].z += bflo(pw.y); o[n].w += bfhi(pw.y); sum += (o[n].x + o[n].y) + (o[n].z + o[n].w); }
            sum += __shfl_xor(sum, 16); sum += __shfl_xor(sum, 32);
            const float mean = sum * (1.f / 64.f); float var = 0.f;
#pragma unroll
            for (int n = 0; n < 4; ++n) { o[n] = o[n] - mean; var += (o[n].x * o[n].x + o[n].y * o[n].y) + (o[n].z * o[n].z + o[n].w * o[n].w); }
            var += __shfl_xor(var, 16); var += __shfl_xor(var, 32);
            const float rstd = rsqrtf(var * (1.f / 64.f) + LN_X_EPS);
#pragma unroll
            for (int n = 0; n < 4; ++n) { const unsigned ao = ((rbk * 4 + n) * 64 + fq * 16 + fr) * 4; const v2u gg = *(const v2u*)(GG + ch + ao), g2 = *(const v2u*)(G2 + ch + ao);
                const f32x4 lw = *(const f32x4*)(A.in[I_LNW] + h * HD + n * 16 + 4 * fq); f32x4 y;
                y.x = (o[n].x * rstd * lw.x + bflo(g2.x)) * bflo(gg.x); y.y = (o[n].y * rstd * lw.y + bfhi(g2.x)) * bfhi(gg.x); y.z = (o[n].z * rstd * lw.z + bflo(g2.y)) * bflo(gg.y); y.w = (o[n].w * rstd * lw.w + bfhi(g2.y)) * bfhi(gg.y);
                *(v2u*)(Y + (size_t)(m0 + tt) * D + DCONV + h * HD + n * 16 + 4 * fq) = pack4(y); }
        }
    }
}
__device__ __forceinline__ void p5_router(const Frame& F, const Args& A, bool commit) {
    const float* H1 = A.out; const float* WrT = (const float*)(A.ws + WS_WRT);
    int* tok_e = (int*)(A.ws + WS_TOK); int* tok_r0 = tok_e + M; int* tok_r1 = tok_e + 2 * M; float* tok_g0 = (float*)(tok_e + 3 * M); float* tok_g1 = (float*)(tok_e + 4 * M); float* tok_rs = (float*)(tok_e + 5 * M);
    LAS float* WS = (LAS float*)F.lds;
    LAS float* lsc = (LAS float*)(F.lds + 40960 + F.wave * 4608);
    for (int tile = blockIdx.x; tile < M / 64; tile += F.G) {
        const int mw = tile * 64 + F.wave * 8;
        float rsv[8]; f32x4 v[8][4];
#pragma unroll
        for (int r = 0; r < 8; ++r) {
            const f32x4* hr = (const f32x4*)(H1 + (size_t)(mw + r) * D) + F.lane; float s = 0.f;
#pragma unroll
            for (int j = 0; j < 4; ++j) { v[r][j] = hr[64 * j]; s += (v[r][j].x * v[r][j].x + v[r][j].y * v[r][j].y) + (v[r][j].z * v[r][j].z + v[r][j].w * v[r][j].w); }
            rsv[r] = rsqrtf(wave_sum(s) * (1.f / D) + RMS_EPS);
        }
#pragma unroll
        for (int j = 0; j < 4; ++j) { const f32x4 gf = *((const f32x4*)A.in[I_GFFN] + F.lane + 64 * j);
#pragma unroll
            for (int r = 0; r < 8; ++r) v[r][j] = v[r][j] * gf; }
#pragma unroll 1
        for (int g = 0; g < 4; ++g) {
            __syncthreads();
            for (int i = F.tid; i < 9 * 256; i += NTHREADS) *(LAS f32x4*)(WS + i * 4) = *(const f32x4*)(WrT + (size_t)g * 9 * D + i * 4);
            __syncthreads();
#pragma unroll 1
            for (int n = 0; n < 9; ++n) {
                const LAS f32x4* wp = (const LAS f32x4*)(WS + n * 1024) + F.lane;
                const f32x4 w0 = wp[0], w1 = wp[64], w2 = wp[128], w3 = wp[192];
#pragma unroll
                for (int r = 0; r < 8; ++r) {
                    float p = (v[r][0].x * w0.x + v[r][0].y * w0.y) + (v[r][0].z * w0.z + v[r][0].w * w0.w);
                    p += (v[r][1].x * w1.x + v[r][1].y * w1.y) + (v[r][1].z * w1.z + v[r][1].w * w1.w);
                    p += (v[r][2].x * w2.x + v[r][2].y * w2.y) + (v[r][2].z * w2.z + v[r][2].w * w2.w);
                    p += (v[r][3].x * w3.x + v[r][3].y * w3.y) + (v[r][3].z * w3.z + v[r][3].w * w3.w);
                    p = dsum16(p);
                    if ((F.lane & 15) == 0) lsc[(r * 36 + g * 9 + n) * 4 + (F.lane >> 4)] = p;
                }
            }
        }
        LDS_WAIT(); asm volatile("" ::: "memory");
#pragma unroll 1
        for (int r = 0; r < 8; ++r) {
            const int m = mw + r; const float rs = rsv[r];
            float lg[36];
#pragma unroll
            for (int n = 0; n < 36; ++n) { const f32x4 q = *(const LAS f32x4*)(lsc + (r * 36 + n) * 4); lg[n] = ((q.x + q.y) + (q.z + q.w)) * rs; }
#pragma unroll
        for (int n = 0; n < NG; ++n) lg[n] += A.in[I_RGB][n];
#pragma unroll
        for (int n = 0; n < NE; ++n) lg[NG + n] += A.in[I_REB][n];
        float gmax = lg[0]; int gi = 0;
#pragma unroll
        for (int j = 1; j < NG; ++j) if (lg[j] > gmax) { gmax = lg[j]; gi = j; }
        float gsum = 0.f;
#pragma unroll
        for (int j = 0; j < NG; ++j) gsum += __expf(lg[j] - gmax);
        const float gprob = 1.0f / gsum;
        float ig[EPG];
#pragma unroll
        for (int j = 0; j < EPG; ++j) ig[j] = (gi == 0) ? lg[NG + j] : ((gi == 1) ? lg[NG + 8 + j] : ((gi == 2) ? lg[NG + 16 + j] : lg[NG + 24 + j]));
        float l0 = ig[0]; int i0 = 0;
#pragma unroll
        for (int j = 1; j < EPG; ++j) if (ig[j] > l0) { l0 = ig[j]; i0 = j; }
        float l1 = -3.0e38f; int i1 = 0;
#pragma unroll
        for (int j = 0; j < EPG; ++j) if (j != i0 && ig[j] > l1) { l1 = ig[j]; i1 = j; }
        const float p0 = 1.0f / (1.0f + __expf(l1 - l0)), p1 = 1.0f - p0;
        if (F.lane == 0 && commit) {
            const int e0 = gi * EPG + i0, e1 = gi * EPG + i1;
            const int r0 = (int)atomicAdd(F.ctl + CW_CNT + 64 * e0, 1u), r1 = (int)atomicAdd(F.ctl + CW_CNT + 64 * e1, 1u);
            tok_e[m] = e0 | (e1 << 8); tok_r0[m] = r0; tok_r1[m] = r1; tok_g0[m] = gprob * p0; tok_g1[m] = gprob * p1; tok_rs[m] = rs;
        }
        }
        LDS_WAIT(); asm volatile("" ::: "memory");
    }
}
__device__ __forceinline__ void expert_convert(const Frame& F, const Args& A, int gw, int NGW) {
    LAS float* scr = (LAS float*)(F.lds + F.wave * 16384);
    bf16* WGU = (bf16*)(A.ws + WS_WGU); bf16* WDt = (bf16*)(A.ws + WS_WD);
    constexpr int IPE = (D / 64) * (DE / 32);
    for (int it = gw; it < 3 * NE * IPE; it += NGW) {
        const int which = it / (NE * IPE), r = it % (NE * IPE), e = r / IPE, q = r % IPE;
        if (which < 2) { const int kb = q / (DE / 32), nb = q % (DE / 32), n0 = 32 * nb;
            transpose_item(A.in[which == 0 ? I_EWG : I_EWU] + (size_t)e * D * DE, DE, 64 * kb, n0, WGU, D, e * 512 + 256 * (n0 >> 7) + (n0 & 127) + (which == 1 ? 128 : 0), scr, F.lane); }
        else { const int kb = q / (D / 32), nb = q % (D / 32);
            transpose_item(A.in[I_EWD] + (size_t)e * DE * D, D, 64 * kb, 32 * nb, WDt, DE, e * D + 32 * nb, scr, F.lane); }
    }
}
__device__ __forceinline__ void load_offsets(const Frame& F, const Args& A) {
    LAS int* offs = (LAS int*)(F.lds + OFFS_OFF);
    LAS int* tile_e = (LAS int*)(F.lds + TILEE_OFF);
    if (F.tid == 0) { int o = 0;
        for (int e = 0; e < NE; ++e) { offs[e] = o; const int c = (int)__hip_atomic_load(F.ctl + CW_CNT + 64 * e, __ATOMIC_RELAXED, __HIP_MEMORY_SCOPE_AGENT); const int o2 = o + ((c + 255) & ~255);
            for (int t = o >> 8; t < (o2 >> 8); ++t) tile_e[t] = e;
            o = o2; }
        offs[NE] = o; }
    __syncthreads();
}
__device__ __forceinline__ void p6a_gather(const Frame& F, const Args& A) {
    load_offsets(F, A);
    const LAS int* offs = (const LAS int*)(F.lds + OFFS_OFF);
    const int gw = blockIdx.x * NWAVES + F.wave, NGW = F.G * NWAVES;
    const float* H1 = A.out; bf16* XS = (bf16*)(A.ws + WS_XS);
    const int* tok_e = (const int*)(A.ws + WS_TOK); const int* tok_r0 = tok_e + M; const int* tok_r1 = tok_e + 2 * M; const float* tok_rs = (const float*)(tok_e + 5 * M);
    int* tok_s0 = (int*)(A.ws + WS_TOK) + 6 * M; int* tok_s1 = tok_s0 + M;
    const f32x4* gf4 = (const f32x4*)A.in[I_GFFN] + F.lane;
    for (int m = gw; m < M; m += NGW) {
        const int ee = tok_e[m], e0 = ee & 255, e1 = (ee >> 8) & 255;
        const int s0 = offs[e0] + tok_r0[m], s1 = offs[e1] + tok_r1[m];
        const float rs = tok_rs[m];
        const f32x4* hr = (const f32x4*)(H1 + (size_t)m * D) + F.lane;
        v2u* o0 = (v2u*)(XS + (size_t)s0 * D) + F.lane; v2u* o1 = (v2u*)(XS + (size_t)s1 * D) + F.lane;
#pragma unroll
        for (int j = 0; j < 4; ++j) { const f32x4 v = hr[64 * j] * rs * gf4[64 * j]; v2u o; o.x = pk2(v.x, v.y); o.y = pk2(v.z, v.w); o0[64 * j] = o; o1[64 * j] = o; }
        if (F.lane == 0) { tok_s0[m] = s0; tok_s1[m] = s1; }
    }
}
__device__ __forceinline__ void p7_final(const Frame& F, const Args& A, float* outp) {
    const int gw = blockIdx.x * NWAVES + F.wave, NGW = F.G * NWAVES;
    const bf16* SO = (const bf16*)(A.ws + WS_SOUT);
    const int* tok_e = (const int*)(A.ws + WS_TOK); const float* tok_g0 = (const float*)(tok_e + 3 * M); const float* tok_g1 = (const float*)(tok_e + 4 * M);
    const int* tok_s0 = tok_e + 6 * M; const int* tok_s1 = tok_s0 + M;
    const f32x4* gf4 = (const f32x4*)A.in[I_GFIN] + F.lane;
    for (int m = gw; m < M; m += NGW) {
        const int s0 = tok_s0[m], s1 = tok_s1[m]; const float g0 = tok_g0[m], g1 = tok_g1[m];
        const f32x4* hr = (const f32x4*)(A.out + (size_t)m * D) + F.lane; f32x4* orow = (f32x4*)(outp + (size_t)m * D) + F.lane;
        const v2u* a0 = (const v2u*)(SO + (size_t)s0 * D) + F.lane; const v2u* a1 = (const v2u*)(SO + (size_t)s1 * D) + F.lane;
        f32x4 v[4]; float s = 0.f;
#pragma unroll
        for (int j = 0; j < 4; ++j) { const v2u x0 = a0[64 * j], x1 = a1[64 * j]; f32x4 h = hr[64 * j];
            h.x += g0 * bf2f((unsigned short)(x0.x & 0xffffu)) + g1 * bf2f((unsigned short)(x1.x & 0xffffu)); h.y += g0 * bf2f((unsigned short)(x0.x >> 16)) + g1 * bf2f((unsigned short)(x1.x >> 16));
            h.z += g0 * bf2f((unsigned short)(x0.y & 0xffffu)) + g1 * bf2f((unsigned short)(x1.y & 0xffffu)); h.w += g0 * bf2f((unsigned short)(x0.y >> 16)) + g1 * bf2f((unsigned short)(x1.y >> 16));
            v[j] = h; s += (h.x * h.x + h.y * h.y) + (h.z * h.z + h.w * h.w); }
        const float rs = rsqrtf(wave_sum(s) * (1.f / D) + RMS_EPS);
#pragma unroll
        for (int j = 0; j < 4; ++j) orow[64 * j] = v[j] * rs * gf4[64 * j];
    }
}

__global__ void __launch_bounds__(NTHREADS, 2) fwd_kernel(Args args) {
    extern __shared__ __attribute__((aligned(16))) unsigned char lds_raw[];
    Frame F;
    F.lds = (LAS unsigned char*)lds_raw;
    F.tid = threadIdx.x; F.lane = F.tid & 63; F.wave = __builtin_amdgcn_readfirstlane(F.tid >> 6); F.G = gridDim.x;
    F.ctl = (unsigned*)(args.ws + WS_CTL);
#define PHASE_ARGS Frame Fp = F; { int l_ = (int)__builtin_amdgcn_mbcnt_hi(~0u, __builtin_amdgcn_mbcnt_lo(~0u, 0u)); asm volatile("" : "+v"(l_)); Fp.lane = l_; Fp.tid = Fp.wave * 64 + l_; }
#define T0_() (F.wave == 0 && __builtin_amdgcn_mbcnt_hi(~0u, __builtin_amdgcn_mbcnt_lo(~0u, 0u)) == 0u)
    const Args& A = args;
    volatile LAS unsigned* MISC = (volatile LAS unsigned*)(F.lds + MISC_OFF);
    for (int u = F.tid; u < (LDS_BYTES - RING_BYTES) / 4; u += NTHREADS) ((LAS unsigned*)(F.lds + RING_BYTES))[u] = 0u;
    __syncthreads();
    const int lo = args.ph_lo, hi = args.ph_hi;
    XcdBarrier bar; bar.bar = F.ctl + CW_BAR; bar.x = 0; bar.st = nullptr;
    if (hi - lo > 1) bar = xcd_barrier_post(F.ctl + CW_BAR, MISC + 8, T0_());
#define IN(k) (lo <= (k) && (k) < hi)
#ifndef PH_MASK
#define PH_MASK 0x1fff
#endif
#define PH_EN(k) (((PH_MASK) >> (k)) & 1)
#ifndef PH_DUP
#define PH_DUP 0
#endif
#define REP(k) for (int rep_ = 0; rep_ < 1 + (((PH_DUP) >> (k)) & 1); ++rep_)
#define SEAM(k) do { if (IN(k) && IN((k) + 1)) xcd_barrier(bar, T0_()); } while (0)
    PB(20); if (PH_EN(0) && IN(0)) REP(0) { PHASE_ARGS p0_prologue(Fp, A); } PE(20); PB(40); SEAM(0); PE(40);
    PB(21); if (PH_EN(1) && IN(1)) REP(1) { PHASE_ARGS
        pg8::Gemm g{(const pg8::bf16_t*)(A.ws + WS_XN), (const pg8::bf16_t*)(A.ws + WS_WIN), M, DIN, D}; pg8::StaticOrder S; S.init(M, DIN, Fp.G, (int)blockIdx.x);
        pg8::EpiZ E{(pg8::bf16_t*)(A.ws + WS_ZC), (pg8::bf16_t*)(A.ws + WS_ZR)};
        pg8::gemm_phase<pg8::EpiZ, pg8::StaticOrder, true, true>(Fp.lds, g, S, E, Fp.tid);
    } PE(21); PB(41); SEAM(1); PE(41);
    PB(22); if (PH_EN(2) && IN(2)) REP(2) { PHASE_ARGS p2a_mix(Fp, A); } PE(22); PB(42); SEAM(2); PE(42);
    PB(23); if (PH_EN(3) && IN(3)) REP(3) { PHASE_ARGS
        int kv = 256; asm volatile("" : "+s"(kv));
        pg8::Gemm g{(const pg8::bf16_t*)(A.ws + WS_LIN), (const pg8::bf16_t*)(A.ws + WS_W3), M, 1536, kv}; pg8::StaticOrder S; S.init(M, 1536, Fp.G, (int)blockIdx.x);
        pg8::EpiLora E{(pg8::bf16_t*)(A.ws + WS_AUX0), (pg8::bf16_t*)(A.ws + WS_AUX1), (pg8::bf16_t*)(A.ws + WS_AUX2), A.in[I_DECBASE], A.in[I_ABASE]};
        pg8::gemm_phase<pg8::EpiLora, pg8::StaticOrder, true, true>(Fp.lds, g, S, E, Fp.tid);
    } PE(23); PB(43); SEAM(3); PE(43);
    PB(24); if (PH_EN(4) && IN(4)) REP(4) { PHASE_ARGS pa_phase(Fp, A); } PE(24); PB(44); SEAM(4); PE(44);
    PB(25); if (PH_EN(5) && IN(5)) REP(5) { PHASE_ARGS
        if ((int)blockIdx.x < BATCH * HEADS) { PB(60); ps_scan(Fp, A, (int)blockIdx.x); PE(60); }
        else { PB(61); expert_convert(Fp, A, ((int)blockIdx.x - BATCH * HEADS) * NWAVES + Fp.wave, (Fp.G - BATCH * HEADS) * NWAVES); PE(61); }
    } PE(25); PB(45); SEAM(5); PE(45);
    PB(26); if (PH_EN(6) && IN(6)) REP(6) { PHASE_ARGS pc_phase(Fp, A); } PE(26); PB(46); SEAM(6); PE(46);
    PB(27); if (PH_EN(7) && IN(7)) REP(7) { PHASE_ARGS
        pg8::Gemm g{(const pg8::bf16_t*)(A.ws + WS_Y), (const pg8::bf16_t*)(A.ws + WS_WOUT), M, D, D}; pg8::StaticOrder S; S.init(M, D, Fp.G, (int)blockIdx.x);
        pg8::EpiResF32 E{A.in[I_X], A.out, D};
        pg8::gemm_phase<pg8::EpiResF32, pg8::StaticOrder, true, true>(Fp.lds, g, S, E, Fp.tid);
    } PE(27); PB(47); SEAM(7); PE(47);
    PB(28); if (PH_EN(8) && IN(8)) REP(8) { PHASE_ARGS p5_router(Fp, A, rep_ == (((PH_DUP) >> 8) & 1)); } PE(28); PB(48); SEAM(8); PE(48);
    PB(29); if (PH_EN(9) && IN(9)) REP(9) { PHASE_ARGS p6a_gather(Fp, A); } PE(29); PB(49); SEAM(9); PE(49);
    PB(30); if (PH_EN(10) && IN(10)) REP(10) { PHASE_ARGS
        load_offsets(Fp, A);
        pg8::Gemm g{(const pg8::bf16_t*)(A.ws + WS_XS), (const pg8::bf16_t*)(A.ws + WS_WGU), MAXSLOTS, 512, D};
        pg8::MoeOrder S; S.init((const LAS int*)(Fp.lds + OFFS_OFF), 2, Fp.G, (int)blockIdx.x, (size_t)512 * D * 2);
        pg8::EpiSwiGLU E{(pg8::bf16_t*)(A.ws + WS_HID), DE};
        pg8::gemm_phase<pg8::EpiSwiGLU, pg8::MoeOrder, true, true>(Fp.lds, g, S, E, Fp.tid);
    } PE(30); PB(50); SEAM(10); PE(50);
    PB(31); if (PH_EN(11) && IN(11)) REP(11) { PHASE_ARGS
        load_offsets(Fp, A);
        int kv = DE; asm volatile("" : "+s"(kv));
        pg8::Gemm g{(const pg8::bf16_t*)(A.ws + WS_HID), (const pg8::bf16_t*)(A.ws + WS_WD), MAXSLOTS, D, kv};
        pg8::MoeOrder S; S.init((const LAS int*)(Fp.lds + OFFS_OFF), 4, Fp.G, (int)blockIdx.x, (size_t)D * DE * 2);
        pg8::EpiPlainBf16 E{(pg8::bf16_t*)(A.ws + WS_SOUT), D};
        pg8::gemm_phase<pg8::EpiPlainBf16, pg8::MoeOrder, true, true>(Fp.lds, g, S, E, Fp.tid);
    } PE(32); PB(51); SEAM(11); PE(51);
    PB(32); if (PH_EN(12) && IN(12)) REP(12) { PHASE_ARGS p7_final(Fp, A, (rep_ == (((PH_DUP) >> 12) & 1)) ? A.out : (float*)(A.ws + WS_XS)); } PE(32);
    if (PROBE_ID >= 0 && PT0_) { const unsigned long long acc_ = *(volatile LAS unsigned long long*)(F.lds + MISC_OFF + 64); const unsigned long long t1_ = __builtin_amdgcn_s_memrealtime() + 8ull * acc_;
        while (__builtin_amdgcn_s_memrealtime() < t1_) __builtin_amdgcn_s_sleep(8); }
#undef IN
#undef SEAM
}

extern "C" void kernel_launch(void* const* d_in, const int* in_sizes, int n_in, void* d_out, int out_size, void* d_ws, size_t ws_size, hipStream_t stream) {
    static int grid = 0;
    if (grid == 0) {
        if (n_in != 25 || in_sizes[0] != M * D || out_size != M * D || ws_size < WS_END) { fprintf(stderr, "kernel_launch: unexpected shapes (n_in %d, in0 %d, out %d, ws %zu)\n", n_in, n_in > 0 ? in_sizes[0] : -1, out_size, ws_size); grid = -1; return; }
        int dev = 0, cus = 0, per_cu = 0;
        if (hipGetDevice(&dev) != hipSuccess || hipDeviceGetAttribute(&cus, hipDeviceAttributeMultiprocessorCount, dev) != hipSuccess) { grid = -1; return; }
        if (hipFuncSetAttribute((const void*)fwd_kernel, hipFuncAttributeMaxDynamicSharedMemorySize, LDS_BYTES) != hipSuccess) { fprintf(stderr, "kernel_launch: hipFuncSetAttribute failed\n"); grid = -1; return; }
        if (hipOccupancyMaxActiveBlocksPerMultiprocessor(&per_cu, (const void*)fwd_kernel, NTHREADS, LDS_BYTES) != hipSuccess || per_cu < 1) { fprintf(stderr, "kernel_launch: occupancy query says %d blocks per CU\n", per_cu); per_cu = 1; }
        (void)hipGetLastError();
        grid = cus;
    }
    if (grid < 0) return;
    (void)hipMemsetAsync((char*)d_ws + WS_CTL, 0, CTL_ZERO_BYTES, stream);
    Args a{};
    for (int i = 0; i < 25; ++i) a.in[i] = (const float*)d_in[i];
    a.out = (float*)d_out; a.ws = (unsigned char*)d_ws;
#if MK_N_LAUNCHES == 1
    a.ph_lo = 0; a.ph_hi = NPHASES;
    void* kargs[] = {&a};
    hipError_t e = hipLaunchCooperativeKernel((const void*)fwd_kernel, dim3(grid), dim3(NTHREADS), kargs, LDS_BYTES, stream);
    if (e != hipSuccess) fprintf(stderr, "kernel_launch: cooperative launch failed: %s (grid %d)\n", hipGetErrorString(e), grid);
#else
    for (int p = 0; p < NPHASES; ++p) { a.ph_lo = p; a.ph_hi = p + 1; hipLaunchKernelGGL(fwd_kernel, dim3(grid), dim3(NTHREADS), LDS_BYTES, stream, a); }
#endif
}
```

```cpp
#include <hip/hip_runtime.h>
#include <cstdio>
#include <cstdint>
namespace pg8 {
#define PG8_LAS __attribute__((address_space(3)))
typedef unsigned short bf16_t;
typedef short bf16x8 __attribute__((ext_vector_type(8)));
typedef float f32x4 __attribute__((ext_vector_type(4)));
typedef unsigned u32x4 __attribute__((ext_vector_type(4)));
constexpr int BM = 256, BK = 64, HALF = 128, HTB = HALF * BK * 2  , STAGE_BYTES = 8 * HTB, NXCD = 8, WGM = 8;

__host__ __device__ __forceinline__ int lds_byte(int r, int c) { const int st = (r >> 4) * 2 + (c >> 5), rr = r & 15, cc = c & 31, ob = rr * 64 + cc * 2; return st * 1024 + (ob ^ (((ob >> 9) & 1) << 5)); }
__host__ __device__ __forceinline__ void stage_rc(int b, int& R, int& C) { const int st = b / 1024, sb = b % 1024, swz = sb ^ (((sb >> 9) & 1) << 5); R = (st >> 1) * 16 + swz / 64; C = (st & 1) * 32 + (swz % 64) / 2; }
__host__ __device__ __forceinline__ int perm32(int rho) { const int n = rho >> 4, i = rho & 15; return 8 * (i >> 2) + 4 * n + (i & 3); }


struct Unit { int pm, pn, e; };
struct Gemm { const bf16_t* A; const bf16_t* Bt; int M, N, K; };

struct StaticOrder {
    int nM, nN, nwg, G, c;
    __host__ __device__ void init(int M, int N, int G_, int c_) { nM = M / BM; nN = N / BM; nwg = nM * nN; G = G_; c = c_; }
    __host__ __device__ bool next(int i, Unit& u) const {
        const long L = (long)i * G + c; if (L >= nwg) return false;
        int wgid = (int)L; { const int q = nwg / NXCD, r = nwg % NXCD, xcd = wgid % NXCD, off = wgid / NXCD; wgid = (xcd < r ? xcd * (q + 1) : r * (q + 1) + (xcd - r) * q) + off; }
        const int nig = WGM * nN, gid = wgid / nig, fm = gid * WGM, gsz = (nM - fm) < WGM ? (nM - fm) : WGM;
        u.pm = fm + ((wgid % nig) % gsz); u.pn = (wgid % nig) / gsz; u.e = 0; return true;
    }
    __device__ __forceinline__ const char* a_ptr(const Gemm& g, const Unit& u, size_t tstep) const { return (const char*)g.A + (size_t)u.pm * tstep; }
    __device__ __forceinline__ const char* b_ptr(const Gemm& g, const Unit& u, size_t tstep) const { return (const char*)g.Bt + (size_t)u.pn * tstep; }
    __device__ __forceinline__ void a_ready(const Unit&) const {}
    __device__ __forceinline__ void done(const Unit&) const {}
};
struct MoeOrder {
    const PG8_LAS int* off; int nct, nunits, G, c; size_t estride;
    __device__ __forceinline__ void init(const PG8_LAS int* off_, int nct_, int G_, int c_, size_t estride_) {
        off = off_; nct = nct_; G = G_; c = (G_ % NXCD == 0) ? (c_ % NXCD) * (G_ / NXCD) + c_ / NXCD : c_;
        estride = estride_; nunits = __builtin_amdgcn_readfirstlane((off_[32] >> 8) * nct_); }
    __device__ __forceinline__ bool next(int i, Unit& u) const {
        const int L = i * G + c; if (L >= nunits) return false;
        const int rt = L / nct, ct = L - rt * nct;
        u.pm = rt; u.pn = ct; u.e = __builtin_amdgcn_readfirstlane(off[96 + rt]); return true;
    }
    __device__ __forceinline__ const char* a_ptr(const Gemm& g, const Unit& u, size_t tstep) const { return (const char*)g.A + (size_t)u.pm * tstep; }
    __device__ __forceinline__ const char* b_ptr(const Gemm& g, const Unit& u, size_t tstep) const { return (const char*)g.Bt + (size_t)u.e * estride + (size_t)u.pn * tstep; }
    __device__ __forceinline__ void a_ready(const Unit&) const {}
    __device__ __forceinline__ void done(const Unit&) const {}
};

struct MoeGatherOrder : MoeOrder {
    const int* gmap;
    __device__ __forceinline__ const char* a_ptr(const Gemm& g, const Unit&, size_t) const { return (const char*)g.A; }
    __device__ __forceinline__ int gather_row(const Unit& u, int r) const {
        const int idx = ((u.pm - (off[u.e] >> 8)) << 8) + r, cnt = off[40 + u.e];
        return (idx < cnt) ? gmap[(u.e << 14) + idx] : 0;
    }
};

__device__ __forceinline__ unsigned cvt_pk_bf16(float lo, float hi) { unsigned r; asm volatile("v_cvt_pk_bf16_f32 %0, %1, %2" : "=v"(r) : "v"(lo), "v"(hi)); return r; }
template <int ACT  > struct EpiBf16 {
    static constexpr bool PERM = true, AFTER_DRAIN = false; static_assert(ACT == 0, "EpiBf16: ACT is 0 (none)");
    bf16_t* O; int ldc; const float* bias; int split_cols; size_t split_stride; float scale0;
    __device__ __forceinline__ void operator()(const f32x4 (&acc)[2][2][4][2], const Unit& u, int wr, int wc, int fr, int fq) const {
        const int row0 = u.pm * BM + wr * 64 + fr; int colt = u.pn * BM; bf16_t* base = O;
        float sc = 1.f; if (split_cols) { const int t = colt / split_cols; base += (size_t)t * split_stride; colt -= t * split_cols; if (t == 0) sc = scale0; }
        const int col0 = colt + wc * 32 + 8 * fq, bcol0 = u.pn * BM + wc * 32 + 8 * fq;
        f32x4 bv[2][2];
#pragma unroll
        for (int bj = 0; bj < 2; ++bj)
#pragma unroll
            for (int n = 0; n < 2; ++n) bv[bj][n] = bias ? *(const f32x4*)(bias + bcol0 + bj * HALF + 4 * n) : (f32x4){0.f, 0.f, 0.f, 0.f};
#pragma unroll
        for (int ai = 0; ai < 2; ++ai)
#pragma unroll
            for (int m = 0; m < 4; ++m) { bf16_t* rowp = base + (size_t)(row0 + ai * HALF + m * 16) * ldc + col0;
#pragma unroll
                for (int bj = 0; bj < 2; ++bj) { f32x4 v0 = acc[ai][bj][m][0] + bv[bj][0], v1 = acc[ai][bj][m][1] + bv[bj][1];
                    v0 = v0 * sc; v1 = v1 * sc; u32x4 w; w.x = cvt_pk_bf16(v0[0], v0[1]); w.y = cvt_pk_bf16(v0[2], v0[3]); w.z = cvt_pk_bf16(v1[0], v1[1]); w.w = cvt_pk_bf16(v1[2], v1[3]);
                    *(u32x4*)(rowp + bj * HALF) = w; } }
    }
};
struct EpiResF32 {
    static constexpr bool PERM = false, AFTER_DRAIN = false;
    const float* base; float* C; int ldc;
    __device__ __forceinline__ void operator()(const f32x4 (&acc)[2][2][4][2], const Unit& u, int wr, int wc, int fr, int fq) const {
        const int row0 = u.pm * BM + wr * 64 + fr, col0 = u.pn * BM + wc * 32 + 4 * fq;
#pragma unroll
        for (int ai = 0; ai < 2; ++ai)
#pragma unroll
            for (int m = 0; m < 4; ++m) { const size_t o = (size_t)(row0 + ai * HALF + m * 16) * ldc + col0;
#pragma unroll
                for (int bj = 0; bj < 2; ++bj)
#pragma unroll
                    for (int n = 0; n < 2; ++n) *(f32x4*)(C + o + bj * HALF + n * 16) = acc[ai][bj][m][n] + *(const f32x4*)(base + o + bj * HALF + n * 16); }
    }
};
__device__ __forceinline__ float silu_f(float x) { return x * __builtin_amdgcn_rcpf(1.0f + __builtin_amdgcn_exp2f(-1.4426950408889634f * x)); }
struct EpiSwiGLU {
    static constexpr bool PERM = true, AFTER_DRAIN = false;
    bf16_t* H; int ldc;
    __device__ __forceinline__ void operator()(const f32x4 (&acc)[2][2][4][2], const Unit& u, int wr, int wc, int fr, int fq) const {
        const int row0 = u.pm * BM + wr * 64 + fr, col0 = u.pn * HALF + wc * 32 + 8 * fq;
#pragma unroll
        for (int ai = 0; ai < 2; ++ai)
#pragma unroll
            for (int m = 0; m < 4; ++m) { bf16_t* rowp = H + (size_t)(row0 + ai * HALF + m * 16) * ldc + col0;
                const f32x4 g0 = acc[ai][0][m][0], g1 = acc[ai][0][m][1], u0 = acc[ai][1][m][0], u1 = acc[ai][1][m][1];
                u32x4 w; w.x = cvt_pk_bf16(silu_f(g0[0]) * u0[0], silu_f(g0[1]) * u0[1]); w.y = cvt_pk_bf16(silu_f(g0[2]) * u0[2], silu_f(g0[3]) * u0[3]);
                w.z = cvt_pk_bf16(silu_f(g1[0]) * u1[0], silu_f(g1[1]) * u1[1]); w.w = cvt_pk_bf16(silu_f(g1[2]) * u1[2], silu_f(g1[3]) * u1[3]);
                *(u32x4*)rowp = w; }
    }
};

struct EpiPlainBf16 {
    static constexpr bool PERM = true, AFTER_DRAIN = false;
    bf16_t* O; int ldc;
    __device__ __forceinline__ void operator()(const f32x4 (&acc)[2][2][4][2], const Unit& u, int wr, int wc, int fr, int fq) const {
        bf16_t* base = O + (size_t)(u.pm * BM + wr * 64 + fr) * ldc + u.pn * BM + wc * 32 + 8 * fq;
#pragma unroll
        for (int ai = 0; ai < 2; ++ai)
#pragma unroll
            for (int m = 0; m < 4; ++m)
#pragma unroll
                for (int bj = 0; bj < 2; ++bj) { const f32x4 v0 = acc[ai][bj][m][0], v1 = acc[ai][bj][m][1];
                    u32x4 w; w.x = cvt_pk_bf16(v0[0], v0[1]); w.y = cvt_pk_bf16(v0[2], v0[3]); w.z = cvt_pk_bf16(v1[0], v1[1]); w.w = cvt_pk_bf16(v1[2], v1[3]);
                    *(u32x4*)(base + (size_t)(ai * HALF + m * 16) * ldc + bj * HALF) = w; }
    }
};
struct EpiZ {
    static constexpr bool PERM = true, AFTER_DRAIN = false;
    bf16_t* ZC; bf16_t* ZR;
    __device__ __forceinline__ void operator()(const f32x4 (&acc)[2][2][4][2], const Unit& u, int wr, int wc, int fr, int fq) const {
        const bool conv = u.pn < 6; bf16_t* base = conv ? ZC : ZR; const int ldc = conv ? 1536 : 1792;
        const int row0 = u.pm * BM + wr * 64 + fr, col0 = (conv ? u.pn : u.pn - 6) * BM + wc * 32 + 8 * fq;
#pragma unroll
        for (int ai = 0; ai < 2; ++ai)
#pragma unroll
            for (int m = 0; m < 4; ++m) { bf16_t* rowp = base + (size_t)(row0 + ai * HALF + m * 16) * ldc + col0;
#pragma unroll
                for (int bj = 0; bj < 2; ++bj) { const f32x4 v0 = acc[ai][bj][m][0], v1 = acc[ai][bj][m][1];
                    u32x4 w; w.x = cvt_pk_bf16(v0[0], v0[1]); w.y = cvt_pk_bf16(v0[2], v0[3]); w.z = cvt_pk_bf16(v1[0], v1[1]); w.w = cvt_pk_bf16(v1[2], v1[3]);
                    *(u32x4*)(rowp + bj * HALF) = w; } }
    }
};
struct EpiLora {
    static constexpr bool PERM = true, AFTER_DRAIN = false;
    bf16_t* LAM; bf16_t* AA; bf16_t* GG; const float* base0; const float* base1;
    __device__ __forceinline__ void operator()(const f32x4 (&acc)[2][2][4][2], const Unit& u, int wr, int wc, int fr, int fq) const {
        const int which = u.pn >> 1, row0 = u.pm * BM + wr * 64 + fr, colb = (u.pn & 1) * BM + wc * 32 + 8 * fq;
        if (which < 2) {
            bf16_t* O = ((which == 0) ? LAM : AA) + (size_t)row0 * 512 + colb; const float* bs = ((which == 0) ? base0 : base1) + colb; const float sc = (which == 0) ? 0.6065306597126334f : 1.0f;
#pragma unroll
            for (int ai = 0; ai < 2; ++ai)
#pragma unroll
                for (int m = 0; m < 4; ++m)
#pragma unroll
                    for (int bj = 0; bj < 2; ++bj)
#pragma unroll
                        for (int n = 0; n < 2; ++n) { f32x4 v = acc[ai][bj][m][n] + *(const f32x4*)(bs + bj * HALF + 4 * n);
#pragma unroll
                            for (int i = 0; i < 4; ++i) v[i] = sc * __builtin_amdgcn_rcpf(1.0f + __builtin_amdgcn_exp2f(-1.4426950408889634f * v[i]));
                            unsigned* d = (unsigned*)(O + (size_t)(ai * HALF + m * 16) * 512 + bj * HALF + 4 * n); d[0] = cvt_pk_bf16(v[0], v[1]); d[1] = cvt_pk_bf16(v[2], v[3]); }
        } else {
            bf16_t* gb = GG + ((size_t)(u.pm * 4 + wr) * 8 + (colb >> 6)) * 4096 + ((((colb & 63) >> 4) * 64) + (((colb & 15) >> 2) * 16) + fr) * 4;
#pragma unroll
            for (int ai = 0; ai < 2; ++ai)
#pragma unroll
                for (int m = 0; m < 4; ++m)
#pragma unroll
                    for (int bj = 0; bj < 2; ++bj)
#pragma unroll
                        for (int n = 0; n < 2; ++n) { const f32x4 v = acc[ai][bj][m][n];
                            unsigned* d = (unsigned*)(gb + (size_t)(ai * 2 * 8 + bj * 2) * 4096 + m * 1024 + n * 64); d[0] = cvt_pk_bf16(v[0], v[1]); d[1] = cvt_pk_bf16(v[2], v[3]); }
        }
    }
};

template <class Epi, class Sched, bool ALIGN_EPI = false, bool SP2 = false, bool GATHER = false>
__device__ __forceinline__ void gemm_phase(PG8_LAS unsigned char* lds, const Gemm g, const Sched& S, const Epi& E, const int tid) {
    const int wid = __builtin_amdgcn_readfirstlane(tid >> 6), lane = tid & 63, wr = wid >> 2, wc = wid & 3, fr = lane & 15, fq = lane >> 4;
    const int K = g.K, nt = K / BK;
    unsigned voffA[2], voffB[2];
#pragma unroll
    for (int i = 0; i < 2; ++i) { int R, C; stage_rc(tid * 16 + i * 8192, R, C); const int Rb = Epi::PERM ? ((R & ~31) + perm32(R & 31)) : R;
        voffA[i] = (unsigned)(R * K + C) * 2u; voffB[i] = (unsigned)(Rb * K + C) * 2u; }
    const size_t kstep = (size_t)(BK * 2);
    const size_t hstep = (size_t)HALF * K * 2;
    const size_t tstep = 2 * hstep;
    const unsigned ldsw = (unsigned)wid * 1024u;
    const int aoff = lds_byte(wr * 64 + fr, fq * 8), boff = lds_byte(wc * 32 + fr, fq * 8);
#define PG8_SA(b, h) (((b) * 2 + (h)) * HTB)
#define PG8_SB(b, h) ((4 + (b) * 2 + (h)) * HTB)
#define PG8_STAGE(bufoff, gbase, voff) do { _Pragma("unroll") for (int _i = 0; _i < 2; ++_i) \
        __builtin_amdgcn_global_load_lds((const unsigned*)((const char*)(gbase) + (voff)[_i]), (PG8_LAS unsigned*)(lds + (bufoff) + ldsw + _i * 8192), 16, 0, 0); } while (0)
#define PG8_STAGEA(bufoff, kptr, half, usenext) do { _Pragma("unroll") for (int _i = 0; _i < 2; ++_i) { \
        const unsigned _vo = GATHER ? ((usenext) ? vAn[half][_i] : vAc[half][_i]) : (voffA[_i] + ((half) ? (unsigned)hstep : 0u)); \
        __builtin_amdgcn_global_load_lds((const unsigned*)((const char*)(kptr) + _vo), (PG8_LAS unsigned*)(lds + (bufoff) + ldsw + _i * 8192), 16, 0, 0); } } while (0)
#define PG8_LDA(dst, b, h) do { _Pragma("unroll") for (int m = 0; m < 4; ++m) _Pragma("unroll") for (int k = 0; k < 2; ++k) dst[m][k] = *(const PG8_LAS bf16x8*)(lds + PG8_SA(b, h) + aoff + m * 2048 + k * 1024); } while (0)
#define PG8_LDB(dst, b, h) do { _Pragma("unroll") for (int n = 0; n < 2; ++n) _Pragma("unroll") for (int k = 0; k < 2; ++k) dst[n][k] = *(const PG8_LAS bf16x8*)(lds + PG8_SB(b, h) + boff + n * 2048 + k * 1024); } while (0)
#define PG8_MMA(ai, bj, At, Bt) do { __builtin_amdgcn_s_setprio(1); _Pragma("unroll") for (int m = 0; m < 4; ++m) _Pragma("unroll") for (int n = 0; n < 2; ++n) _Pragma("unroll") for (int k = 0; k < 2; ++k) \
        acc[ai][bj][m][n] = __builtin_amdgcn_mfma_f32_16x16x32_bf16(Bt[n][k], At[m][k], acc[ai][bj][m][n], 0, 0, 0); __builtin_amdgcn_s_setprio(0); } while (0)
#define PG8_WAIT_V(n) asm volatile("s_waitcnt vmcnt(" #n ")" ::: "memory")
#define PG8_WAIT_L(n) asm volatile("s_waitcnt lgkmcnt(" #n ")" ::: "memory")
#define PG8_BAR __builtin_amdgcn_s_barrier()
#define PG8_SCHED __builtin_amdgcn_sched_barrier(0)
    Unit cur, nxt; int ui = 0;
    if (!S.next(0, cur)) return;
    unsigned vAc[2][2] = {{0u, 0u}, {0u, 0u}}, vAn[2][2] = {{0u, 0u}, {0u, 0u}};
    if constexpr (GATHER) {
#pragma unroll
        for (int hf = 0; hf < 2; ++hf)
#pragma unroll
            for (int i = 0; i < 2; ++i) { int R, C; stage_rc(tid * 16 + i * 8192, R, C); vAc[hf][i] = (unsigned)(S.gather_row(cur, hf * HALF + R) * K + C) * 2u; }
    }
    f32x4 acc[2][2][4][2];
#pragma unroll
    for (int a = 0; a < 2; ++a)
#pragma unroll
        for (int b = 0; b < 2; ++b)
#pragma unroll
            for (int m = 0; m < 4; ++m)
#pragma unroll
                for (int n = 0; n < 2; ++n) acc[a][b][m][n] = (f32x4){0.f, 0.f, 0.f, 0.f};
    bf16x8 At[4][2], B0[2][2], B1[2][2];
    const char* cA = S.a_ptr(g, cur, tstep); const char* cB = S.b_ptr(g, cur, tstep);
    S.a_ready(cur);
    if constexpr (SP2) {
        PG8_STAGE(PG8_SB(0, 0), cB, voffB); PG8_STAGE(PG8_SB(0, 1), cB + hstep, voffB); PG8_STAGEA(PG8_SA(0, 0), cA, 0, false); PG8_STAGEA(PG8_SA(0, 1), cA, 1, false);
        if (wr == 1) PG8_BAR;
        PG8_WAIT_V(2); PG8_BAR;
        PG8_STAGE(PG8_SB(1, 0), cB + kstep, voffB); PG8_STAGEA(PG8_SA(1, 0), cA + kstep, 0, false); PG8_STAGE(PG8_SB(1, 1), cB + hstep + kstep, voffB);
        PG8_WAIT_V(6); PG8_BAR;
    } else {
        static_assert(SP2 || !GATHER, "row gather is implemented for the SP2 loop only");
        PG8_STAGE(PG8_SB(0, 0), cB, voffB); PG8_STAGE(PG8_SA(0, 0), cA, voffA); PG8_STAGE(PG8_SB(0, 1), cB + hstep, voffB); PG8_STAGE(PG8_SA(0, 1), cA + hstep, voffA);
        if (wr == 1) PG8_BAR;
        PG8_WAIT_V(4); PG8_BAR;
        PG8_STAGE(PG8_SB(1, 0), cB + kstep, voffB); PG8_STAGE(PG8_SA(1, 0), cA + kstep, voffA); PG8_STAGE(PG8_SB(1, 1), cB + hstep + kstep, voffB);
        PG8_WAIT_V(6); PG8_BAR;
    }
    for (;;) {
        const bool has_next = S.next(ui + 1, nxt);
        const char* nA = has_next ? S.a_ptr(g, nxt, tstep) : cA; const char* nB = has_next ? S.b_ptr(g, nxt, tstep) : cB;
        if constexpr (GATHER) { if (has_next) {
#pragma unroll
            for (int hf = 0; hf < 2; ++hf)
#pragma unroll
                for (int i = 0; i < 2; ++i) { int R, C; stage_rc(tid * 16 + i * 8192, R, C); vAn[hf][i] = (unsigned)(S.gather_row(nxt, hf * HALF + R) * K + C) * 2u; } } }
        for (int t = 0; t < nt; t += 2) {
            const bool last = (t == nt - 2); const bool unx = last && has_next;
            const char* a1 = cA + (size_t)(t + 1) * kstep;
            const char* a2 = last ? nA : cA + (size_t)(t + 2) * kstep; const char* b2 = last ? nB : cB + (size_t)(t + 2) * kstep;
            const char* a3 = a2 + kstep; const char* b3 = b2 + kstep;
            if (last && has_next) S.a_ready(nxt);
            if constexpr (SP2) {
            PG8_LDB(B0, 0, 0); PG8_LDB(B1, 0, 1); PG8_SCHED; PG8_LDA(At, 0, 0); PG8_STAGEA(PG8_SA(1, 1), a1, 1, false);
            PG8_WAIT_V(8); PG8_WAIT_L(0); PG8_BAR; PG8_MMA(0, 0, At, B0); PG8_MMA(0, 1, At, B1); PG8_BAR; PG8_SCHED;
            PG8_LDA(At, 0, 1); PG8_STAGE(PG8_SB(0, 0), b2, voffB); PG8_STAGE(PG8_SB(0, 1), b2 + hstep, voffB); PG8_STAGEA(PG8_SA(0, 0), a2, 0, unx);
            PG8_WAIT_V(8); PG8_WAIT_L(0); PG8_BAR; PG8_MMA(1, 0, At, B0); PG8_MMA(1, 1, At, B1); PG8_BAR; PG8_SCHED;
            PG8_LDB(B0, 1, 0); PG8_LDB(B1, 1, 1); PG8_SCHED; PG8_LDA(At, 1, 0); PG8_STAGEA(PG8_SA(0, 1), a2, 1, unx);
            PG8_WAIT_V(8); PG8_WAIT_L(0); PG8_BAR; PG8_MMA(0, 0, At, B0); PG8_MMA(0, 1, At, B1); PG8_BAR; PG8_SCHED;
            PG8_LDA(At, 1, 1); PG8_STAGE(PG8_SB(1, 0), b3, voffB); PG8_STAGE(PG8_SB(1, 1), b3 + hstep, voffB); PG8_STAGEA(PG8_SA(1, 0), a3, 0, unx);
            PG8_WAIT_V(8); PG8_WAIT_L(0); PG8_BAR; PG8_MMA(1, 0, At, B0); PG8_MMA(1, 1, At, B1); PG8_BAR; PG8_SCHED;
            } else {
            PG8_LDB(B0, 0, 0); PG8_SCHED; PG8_LDA(At, 0, 0); PG8_STAGE(PG8_SA(1, 1), a1 + hstep, voffA);
            PG8_WAIT_L(8); PG8_BAR; PG8_WAIT_L(0); PG8_MMA(0, 0, At, B0); PG8_BAR; PG8_SCHED;
            PG8_LDB(B1, 0, 1); PG8_STAGE(PG8_SB(0, 0), b2, voffB);
            PG8_BAR; PG8_WAIT_L(0); PG8_MMA(0, 1, At, B1); PG8_BAR;
            PG8_LDA(At, 0, 1); PG8_STAGE(PG8_SA(0, 0), a2, voffA);
            PG8_BAR; PG8_WAIT_L(0); PG8_MMA(1, 0, At, B0); PG8_BAR; PG8_SCHED;
            PG8_STAGE(PG8_SB(0, 1), b2 + hstep, voffB);
            PG8_WAIT_V(6); PG8_BAR; PG8_MMA(1, 1, At, B1); PG8_BAR;
            PG8_LDB(B0, 1, 0); PG8_SCHED; PG8_LDA(At, 1, 0); PG8_STAGE(PG8_SA(0, 1), a2 + hstep, voffA);
            PG8_WAIT_L(8); PG8_BAR; PG8_WAIT_L(0); PG8_MMA(0, 0, At, B0); PG8_BAR; PG8_SCHED;
            PG8_LDB(B1, 1, 1); PG8_STAGE(PG8_SB(1, 0), b3, voffB);
            PG8_BAR; PG8_WAIT_L(0); PG8_MMA(0, 1, At, B1); PG8_BAR;
            PG8_LDA(At, 1, 1); PG8_STAGE(PG8_SA(1, 0), a3, voffA);
            PG8_BAR; PG8_WAIT_L(0); PG8_MMA(1, 0, At, B0); PG8_BAR; PG8_SCHED;
            PG8_STAGE(PG8_SB(1, 1), b3 + hstep, voffB);
            PG8_WAIT_V(6); PG8_BAR; PG8_MMA(1, 1, At, B1); PG8_BAR;
            }
        }
        if constexpr (ALIGN_EPI) { if (wr == 0) PG8_BAR; }
        if constexpr (!Epi::AFTER_DRAIN) { E(acc, cur, wr, wc, fr, fq); S.done(cur); }
        if (!has_next) break;
#pragma unroll
        for (int a = 0; a < 2; ++a)
#pragma unroll
            for (int b = 0; b < 2; ++b)
#pragma unroll
                for (int m = 0; m < 4; ++m)
#pragma unroll
                    for (int n = 0; n < 2; ++n) acc[a][b][m][n] = (f32x4){0.f, 0.f, 0.f, 0.f};
        cur = nxt; cA = nA; cB = nB; ++ui;
        if constexpr (GATHER) { vAc[0][0] = vAn[0][0]; vAc[0][1] = vAn[0][1]; vAc[1][0] = vAn[1][0]; vAc[1][1] = vAn[1][1]; }
        if constexpr (ALIGN_EPI) { if (wr == 1) PG8_BAR; }
    }
    PG8_WAIT_V(0);
    if constexpr (!ALIGN_EPI) { if (wr == 0) PG8_BAR; }
    PG8_BAR;
    if constexpr (Epi::AFTER_DRAIN) { E.fused(acc, cur, wr, wc, fr, fq, lds, wid, lane); S.done(cur); }
#undef PG8_SA
#undef PG8_SB
#undef PG8_STAGE
#undef PG8_STAGEA
#undef PG8_LDA
#undef PG8_LDB
#undef PG8_MMA
#undef PG8_WAIT_V
#undef PG8_WAIT_L
#undef PG8_BAR
#undef PG8_SCHED
}
}
constexpr int NWAVES = 8, NTHREADS = NWAVES * 64;
constexpr int BATCH = 8, SEQ = 2048, D = 1024, M = BATCH * SEQ;
constexpr int DCONV = 512, DRWKV = 512, HEADS = 8, HD = 64;
constexpr int DIN = 3328;
constexpr int ZR = 1536, ZK = 2048, ZV = 2560, ZLO = 3072;
constexpr int NE = 32, NG = 4, EPG = 8, DE = 256;
constexpr int MAXSLOTS = 41216;
constexpr float RMS_EPS = 1e-6f, LN_X_EPS = 64e-5f;
#ifndef MK_N_LAUNCHES
#define MK_N_LAUNCHES 1
#endif
constexpr int NPHASES = 11;
constexpr size_t MiB = 1u << 20;
constexpr size_t WS_CTL = 0, CTL_ZERO_BYTES = 64 * 1024;
constexpr size_t WS_WRT = 1 * MiB;
constexpr size_t WS_TOK = 1 * MiB + 256 * 1024;
constexpr size_t WS_WIN = 4 * MiB, WS_WOUT = 2 * MiB;
constexpr size_t WS_XN = 12 * MiB;
constexpr size_t WS_ZC = 44 * MiB, WS_ZR = 92 * MiB, WS_Y = 148 * MiB;
constexpr int LDZC = 1536, LDZR = 1792;
constexpr size_t WS_LIN = 180 * MiB, WS_W3 = 188 * MiB;
constexpr size_t WS_AUX0 = 4 * MiB, WS_AUX1 = 20 * MiB, WS_AUX2 = 36 * MiB;
constexpr size_t WS_PHT = 52 * MiB, WS_PSI = 68 * MiB, WS_QQ = 190 * MiB, WS_PP = 206 * MiB, WS_G2 = 222 * MiB;
constexpr size_t WS_HN = 4 * MiB, WS_TOKMAP = 40 * MiB;
constexpr size_t WS_WGU = 92 * MiB, WS_WD = 124 * MiB, WS_XS = 4 * MiB, WS_HID = 221 * MiB, WS_SOUT = 140 * MiB, WS_END = 242 * MiB;
static_assert(WS_WOUT + (size_t)D * D * 2 <= WS_WIN && WS_WIN + (size_t)DIN * D * 2 <= WS_XN, "ws map");
static_assert(WS_XS + (size_t)MAXSLOTS * D * 2 <= WS_WGU && WS_SOUT + (size_t)MAXSLOTS * D * 2 <= WS_HID && WS_HID + (size_t)MAXSLOTS * DE * 2 <= WS_END && WS_WD + (size_t)NE * D * DE * 2 <= WS_SOUT, "ws map");
static_assert(WS_ZC + (size_t)M * LDZC * 2 <= WS_ZR && WS_ZR + (size_t)M * LDZR * 2 <= WS_Y && WS_Y + (size_t)M * D * 2 <= WS_LIN && WS_W3 + 1536 * 256 * 2 <= WS_QQ, "ws map");
constexpr int CW_TMO = 0, CW_BAR = 1024, CW_CNT = 8192;
constexpr int RING_BYTES = 131072, LDS_BYTES = 163840, MISC_OFF = LDS_BYTES - 2048, OFFS_OFF = MISC_OFF + 128, CNTS_OFF = OFFS_OFF + 160, TILEE_OFF = OFFS_OFF + 384;

#define GAS __attribute__((address_space(1)))
#define LAS __attribute__((address_space(3)))
typedef unsigned short bf16;
typedef unsigned v4u __attribute__((ext_vector_type(4)));
typedef unsigned v2u __attribute__((ext_vector_type(2)));
typedef float f32x4 __attribute__((ext_vector_type(4)));
typedef unsigned short us4 __attribute__((ext_vector_type(4)));
#define LDS_WAIT() asm volatile("s_waitcnt lgkmcnt(0)" ::: "memory")
typedef float f32x2_t __attribute__((ext_vector_type(2)));
typedef __bf16 bf16x2_t __attribute__((ext_vector_type(2)));
__device__ __forceinline__ unsigned pk2(float lo, float hi) { const f32x2_t v = {lo, hi}; const bf16x2_t b = __builtin_convertvector(v, bf16x2_t); return __builtin_bit_cast(unsigned, b); }
__device__ __forceinline__ unsigned f2bf(float f) { return pk2(f, 0.f) & 0xffffu; }
__device__ __forceinline__ float bf2f(unsigned short b) { return __builtin_bit_cast(float, (unsigned)b << 16); }
__device__ __forceinline__ float sigmoid_f(float x) { return 1.0f / (1.0f + __expf(-x)); }


#ifndef PROBE_ID
#define PROBE_ID -1
#endif
#define PT0_ (F.wave == 0 && __builtin_amdgcn_mbcnt_hi(~0u, __builtin_amdgcn_mbcnt_lo(~0u, 0u)) == 0u)
#define PB(id) do { if (PROBE_ID == (id) && PT0_) { *(volatile LAS unsigned long long*)(F.lds + MISC_OFF + 72) = __builtin_amdgcn_s_memrealtime(); } } while (0)
#define PE(id) do { if (PROBE_ID == (id) && PT0_) { volatile LAS unsigned long long* pp_ = (volatile LAS unsigned long long*)(F.lds + MISC_OFF + 64); pp_[0] = pp_[0] + (__builtin_amdgcn_s_memrealtime() - pp_[1]); } } while (0)
#define XB_TMO      128
#define XB_XCNT(j)  (256  + 64 * (j))
#define XB_XSUB(j)  (1280 + 64 * (j))
#define XB_XGEN(j)  (2304 + 64 * (j))
#define XB_TOP      3328
#define XB_TOPGEN   3392
#define XCD_BAR_WORDS 3456
#define XB_SPIN_CAP (1u << 18)
__device__ __forceinline__ unsigned xb_ld(unsigned* p)              { return __hip_atomic_load(p, __ATOMIC_RELAXED, __HIP_MEMORY_SCOPE_AGENT); }
__device__ __forceinline__ unsigned xb_add(unsigned* p, unsigned v) { return __hip_atomic_fetch_add(p, v, __ATOMIC_RELAXED, __HIP_MEMORY_SCOPE_AGENT); }
__device__ __forceinline__ unsigned xb_xcc_id() { return (unsigned)__builtin_amdgcn_s_getreg((3 << 11) | 20) & 0xFu; }
#define XB_SPIN(cond, bar) do { unsigned _sp = 0; while (cond) { __builtin_amdgcn_s_sleep(1); \
    if ((++_sp & 255u) == 0u) { if (xb_ld(&(bar)[XB_TMO])) break; if (_sp > XB_SPIN_CAP) { atomicAdd(&(bar)[XB_TMO], 1u); break; } } } } while (0)
struct XcdBarrier { unsigned* bar; unsigned x; volatile LAS unsigned* st; };
__device__ __forceinline__ XcdBarrier xcd_barrier_post(unsigned* bar, volatile LAS unsigned* st, bool t0) {
    XcdBarrier b; b.bar = bar; b.x = xb_xcc_id(); b.st = st;
    if (t0) (void)xb_add(&bar[XB_XCNT(b.x)], 1u);
    return b;
}
__device__ __forceinline__ void xcd_barrier_complete(unsigned* bar, unsigned x, unsigned& nloc, unsigned& nx) {
    const unsigned G = gridDim.x * gridDim.y * gridDim.z;
    unsigned sum, cnt, mine, sp = 0u;
    for (;;) {
        sum = 0u; cnt = 0u; mine = 0u;
#pragma unroll
        for (unsigned j = 0; j < 16; ++j) { const unsigned c = xb_ld(&bar[XB_XCNT(j)]); sum += c; cnt += (c > 0u) ? 1u : 0u; mine = (j == x) ? c : mine; }
        if (sum == G) break;
        __builtin_amdgcn_s_sleep(1);
        if ((++sp & 255u) == 0u) { if (xb_ld(&bar[XB_TMO])) break; if (sp > XB_SPIN_CAP) { atomicAdd(&bar[XB_TMO], 1u); break; } }
    }
    nloc = mine > 0u ? mine : 1u; nx = cnt > 0u ? cnt : 1u;
}
__device__ __forceinline__ void xcd_barrier(const XcdBarrier& b, bool t0) {
    asm volatile("s_waitcnt vmcnt(0)" ::: "memory");
    __syncthreads();
    if (t0) {
        unsigned* bar = b.bar;
        __builtin_amdgcn_s_waitcnt(0);
        unsigned nloc = b.st[0], nx = b.st[1];
        if (nloc == 0u) { xcd_barrier_complete(bar, b.x, nloc, nx); b.st[0] = nloc; b.st[1] = nx; }
        const unsigned old = xb_add(&bar[XB_XSUB(b.x)], 1u);
        const unsigned gen = old / nloc;
        if (old + 1u == (gen + 1u) * nloc) {
            __builtin_amdgcn_fence(__ATOMIC_RELEASE, "agent");
            asm volatile("s_waitcnt vmcnt(0)" ::: "memory");
            const unsigned og = xb_add(&bar[XB_TOP], 1u);
            const unsigned tg = og / nx;
            if (og + 1u == (tg + 1u) * nx) xb_add(&bar[XB_TOPGEN], 1u);
            else XB_SPIN(xb_ld(&bar[XB_TOPGEN]) == tg, bar);
            __builtin_amdgcn_fence(__ATOMIC_ACQUIRE, "agent");
            xb_add(&bar[XB_XGEN(b.x)], 1u);
            asm volatile("s_waitcnt vmcnt(0)" ::: "memory");
        } else {
            XB_SPIN(xb_ld(&bar[XB_XGEN(b.x)]) == gen, bar);
            __builtin_amdgcn_fence(__ATOMIC_ACQUIRE, "agent");
            asm volatile("s_waitcnt vmcnt(0)" ::: "memory");
        }
    }
    __syncthreads();
}

struct Args { const float* in[25]; float* out; unsigned char* ws; int ph_lo, ph_hi; };
struct Frame {
    LAS unsigned char* lds;
    int tid, lane, wave, G;
    unsigned* ctl;
};
enum InIdx { I_X = 0, I_G1, I_WIN, I_MU, I_CONVW, I_DECUP, I_DECBASE, I_AUP, I_ABASE, I_GUP, I_KK, I_KA, I_RK, I_LNW, I_LNB, I_WOUT, I_GFFN, I_RGW, I_RGB, I_REW, I_REB, I_EWG, I_EWU, I_EWD, I_GFIN };

__device__ __forceinline__ float wave_sum(float v) {
#pragma unroll
    for (int o = 1; o < 64; o <<= 1) v += __shfl_xor(v, o);
    return v;
}
__device__ __forceinline__ float sum16(float v) { v += __shfl_xor(v, 1); v += __shfl_xor(v, 2); v += __shfl_xor(v, 4); v += __shfl_xor(v, 8); return v; }
__device__ __forceinline__ float sum8(float v) { v += __shfl_xor(v, 1); v += __shfl_xor(v, 2); v += __shfl_xor(v, 4); return v; }

__device__ __forceinline__ void transpose_item(const float* W, int N, int k0, int n0, bf16* WT, int ldk, int drow0, LAS float* scr, int lane) {
    float tv[32];
#pragma unroll
    for (int i = 0; i < 32; ++i) tv[i] = W[(size_t)(k0 + 2 * i + (lane >> 5)) * N + n0 + (lane & 31)];
#pragma unroll
    for (int i = 0; i < 32; ++i) scr[(2 * i + (lane >> 5)) * 33 + (lane & 31)] = tv[i];
    LDS_WAIT(); asm volatile("" ::: "memory");
    const int c = lane & 7;
#pragma unroll
    for (int j = 0; j < 4; ++j) { const int n = (lane >> 3) + 8 * j; const LAS float* s = scr + (8 * c) * 33 + n;
        v4u o; o.x = pk2(s[0 * 33], s[1 * 33]); o.y = pk2(s[2 * 33], s[3 * 33]); o.z = pk2(s[4 * 33], s[5 * 33]); o.w = pk2(s[6 * 33], s[7 * 33]);
        *(v4u*)(WT + (size_t)(drow0 + n) * ldk + k0 + 8 * c) = o; }
    LDS_WAIT(); asm volatile("" ::: "memory");
}

__device__ __forceinline__ void p0_prologue(const Frame& F, const Args& A) {
    LAS float* scr = (LAS float*)(F.lds + F.wave * 16384);
    const int gw = blockIdx.x * NWAVES + F.wave, NGW = F.G * NWAVES;
    bf16* WinT = (bf16*)(A.ws + WS_WIN); bf16* WoutT = (bf16*)(A.ws + WS_WOUT);
    constexpr int I_IN = (D / 64) * (DIN / 32), I_OUT = (D / 64) * (D / 32);
    for (int it = gw; it < I_IN + I_OUT; it += NGW) {
        if (it < I_IN) { const int kb = it / (DIN / 32), nb = it % (DIN / 32); transpose_item(A.in[I_WIN], DIN, 64 * kb, 32 * nb, WinT, D, 32 * nb, scr, F.lane); }
        else { const int r = it - I_IN, kb = r / (D / 32), nb = r % (D / 32); transpose_item(A.in[I_WOUT], D, 64 * kb, 32 * nb, WoutT, D, 32 * nb, scr, F.lane); }
    }
    { bf16* WRH = (bf16*)(A.ws + WS_WRT); bf16* WRL = WRH + 3 * 32 * 64 * 8;
      for (int i = blockIdx.x * NTHREADS + F.tid; i < 3 * 32 * 64 * 8; i += F.G * NTHREADS) { const int j = i & 7, ln = (i >> 3) & 63, ks = (i >> 9) & 31, nt = i >> 14;
          const int n = nt * 16 + (ln & 15), k = ks * 32 + (ln >> 4) * 8 + j; float w = 0.f;
          if (n < NG) w = A.in[I_RGW][k * NG + n]; else if (n < NG + NE) w = A.in[I_REW][k * NE + (n - NG)];
          const unsigned hb = f2bf(w); const float hf = __builtin_bit_cast(float, hb << 16);
          WRH[i] = (bf16)hb; WRL[i] = (bf16)f2bf(w - hf); } }
    { bf16* W3F = (bf16*)(A.ws + WS_W3);
      for (int i = blockIdx.x * NTHREADS + F.tid; i < 256 * 512; i += F.G * NTHREADS) { const int j = i & 7, ln = (i >> 3) & 63, blk = i >> 9;
          const int which = blk < 64 ? 0 : (blk < 128 ? 1 : 2), b2 = blk - (which == 2 ? 128 : which * 64), nks = (which == 2) ? 4 : 2, ct = b2 / nks, ks = b2 % nks;
          const int n = ct * 16 + (ln & 15), k = ks * 32 + (ln >> 4) * 8 + j;
          const float v = (which == 0) ? A.in[I_DECUP][k * 512 + n] : ((which == 1) ? A.in[I_AUP][k * 512 + n] : A.in[I_GUP][k * 512 + n]);
          W3F[i] = (bf16)f2bf(v); } }
    bf16* XN = (bf16*)(A.ws + WS_XN);
    const f32x4* g4 = (const f32x4*)A.in[I_G1] + F.lane;
    {
        f32x4 va[4], vb[4];
        int m = gw;
        if (m < M) { const f32x4* xr = (const f32x4*)(A.in[I_X] + (size_t)m * D) + F.lane;
#pragma unroll
            for (int j = 0; j < 4; ++j) va[j] = xr[64 * j]; }
#pragma unroll 1
        for (; m < M; m += 2 * NGW) {
#pragma unroll
            for (int u = 0; u < 2; ++u) {
                f32x4 (&v)[4] = u ? vb : va; f32x4 (&vn)[4] = u ? va : vb; const int mc = m + u * NGW, mn = mc + NGW;
                if (mn < M) { const f32x4* xr = (const f32x4*)(A.in[I_X] + (size_t)mn * D) + F.lane;
#pragma unroll
                    for (int j = 0; j < 4; ++j) vn[j] = xr[64 * j]; }
                if (mc < M) { float s = 0.f;
#pragma unroll
                    for (int j = 0; j < 4; ++j) s += (v[j].x * v[j].x + v[j].y * v[j].y) + (v[j].z * v[j].z + v[j].w * v[j].w);
                    const float rs = rsqrtf(wave_sum(s) * (1.f / D) + RMS_EPS);
                    v2u* o8 = (v2u*)(XN + (size_t)mc * D) + F.lane;
#pragma unroll
                    for (int j = 0; j < 4; ++j) { const f32x4 g = g4[64 * j]; v2u o; o.x = pk2(v[j].x * rs * g.x, v[j].y * rs * g.y); o.y = pk2(v[j].z * rs * g.z, v[j].w * rs * g.w); o8[64 * j] = o; } }
            }
        }
    }
}

__device__ __forceinline__ float bflo(unsigned w) { return __builtin_bit_cast(float, w << 16); }
__device__ __forceinline__ float bfhi(unsigned w) { return __builtin_bit_cast(float, w & 0xffff0000u); }
__device__ __forceinline__ void p2a_mix(const Frame& F, const Args& A) {
    constexpr int LIN_LD = 264;
    const bf16* ZC = (const bf16*)(A.ws + WS_ZC); const bf16* ZR = (const bf16*)(A.ws + WS_ZR); bf16* Y = (bf16*)(A.ws + WS_Y); LAS bf16* LINs = (LAS bf16*)F.lds;
    for (int it = blockIdx.x; it < M / 64; it += F.G) {
        const int m0 = it * 64;
        {
            const int c8 = (F.tid & 63) * 8, r0 = m0 + (F.tid >> 6) * 8, ts = r0 % SEQ;
            float w0[8], w1[8], w2[8];
#pragma unroll
            for (int q = 0; q < 8; ++q) { w0[q] = A.in[I_CONVW][c8 + q]; w1[q] = A.in[I_CONVW][512 + c8 + q]; w2[q] = A.in[I_CONVW][1024 + c8 + q]; }
            float ch2[8], ch1[8];
#pragma unroll
            for (int q = 0; q < 8; ++q) { ch2[q] = 0.f; ch1[q] = 0.f; }
            if (ts != 0) {
                const v4u c2 = *(const v4u*)(ZC + (size_t)(r0 - 2) * LDZC + 512 + c8), h2 = *(const v4u*)(ZC + (size_t)(r0 - 2) * LDZC + 1024 + c8);
                const v4u c1 = *(const v4u*)(ZC + (size_t)(r0 - 1) * LDZC + 512 + c8), h1 = *(const v4u*)(ZC + (size_t)(r0 - 1) * LDZC + 1024 + c8);
#pragma unroll
                for (int q = 0; q < 4; ++q) { ch2[2 * q] = bflo(c2[q]) * bflo(h2[q]); ch2[2 * q + 1] = bfhi(c2[q]) * bfhi(h2[q]); ch1[2 * q] = bflo(c1[q]) * bflo(h1[q]); ch1[2 * q + 1] = bfhi(c1[q]) * bfhi(h1[q]); }
            }
#pragma unroll
            for (int i = 0; i < 8; ++i) {
                const bf16* zr = ZC + (size_t)(r0 + i) * LDZC;
                const v4u bg = *(const v4u*)(zr + c8), cg = *(const v4u*)(zr + 512 + c8), hh = *(const v4u*)(zr + 1024 + c8);
                float y[8];
#pragma unroll
                for (int q = 0; q < 4; ++q) {
                    const float ca = bflo(cg[q]) * bflo(hh[q]), cb = bfhi(cg[q]) * bfhi(hh[q]);
                    y[2 * q] = bflo(bg[q]) * (w0[2 * q] * ch2[2 * q] + w1[2 * q] * ch1[2 * q] + w2[2 * q] * ca);
                    y[2 * q + 1] = bfhi(bg[q]) * (w0[2 * q + 1] * ch2[2 * q + 1] + w1[2 * q + 1] * ch1[2 * q + 1] + w2[2 * q + 1] * cb);
                    ch2[2 * q] = ch1[2 * q]; ch1[2 * q] = ca; ch2[2 * q + 1] = ch1[2 * q + 1]; ch1[2 * q + 1] = cb; }
                v4u o; o.x = pk2(y[0], y[1]); o.y = pk2(y[2], y[3]); o.z = pk2(y[4], y[5]); o.w = pk2(y[6], y[7]);
                *(v4u*)(Y + (size_t)(r0 + i) * D + c8) = o;
            }
        }
        __syncthreads();
        {
            const int j8 = (F.tid & 31) * 8; float mu[8];
#pragma unroll
            for (int q = 0; q < 8; ++q) mu[q] = A.in[I_MU][1536 + j8 + q];
#pragma unroll
            for (int i = 0; i < 4; ++i) {
                const int tl = (F.tid >> 5) + 16 * i, m = m0 + tl;
                const v4u zc = *(const v4u*)(ZR + (size_t)m * LDZR + 1536 + j8); v4u zp = {0u, 0u, 0u, 0u};
                if ((m % SEQ) > 0) zp = *(const v4u*)(ZR + (size_t)(m - 1) * LDZR + 1536 + j8);
                float f[8];
#pragma unroll
                for (int q = 0; q < 4; ++q) { const float a = bflo(zc[q]), b = bfhi(zc[q]); f[2 * q] = a + (bflo(zp[q]) - a) * mu[2 * q]; f[2 * q + 1] = b + (bfhi(zp[q]) - b) * mu[2 * q + 1]; }
                if (j8 < 64) {
#pragma unroll
                    for (int q = 0; q < 8; ++q) f[q] = tanhf(f[q]); }
                else if (j8 >= 128) {
#pragma unroll
                    for (int q = 0; q < 8; ++q) f[q] = sigmoid_f(f[q]); }
                v4u o; o.x = pk2(f[0], f[1]); o.y = pk2(f[2], f[3]); o.z = pk2(f[4], f[5]); o.w = pk2(f[6], f[7]);
                *(LAS v4u*)(LINs + tl * LIN_LD + j8) = o;
            }
        }
        __syncthreads();
        {
            typedef short bf16x8_l __attribute__((ext_vector_type(8)));
            const int fr = F.lane & 15, fq = F.lane >> 4, rb = F.wave & 3, chh = F.wave >> 2;
            bf16x8_l af[8];
#pragma unroll
            for (int ks = 0; ks < 8; ++ks) af[ks] = *(const LAS bf16x8_l*)(LINs + (rb * 16 + fr) * LIN_LD + ks * 32 + fq * 8);
            const bf16* W3F = (const bf16*)(A.ws + WS_W3);
            bf16* LAMg = (bf16*)(A.ws + WS_AUX0); bf16* AAg = (bf16*)(A.ws + WS_AUX1); bf16* GGg = (bf16*)(A.ws + WS_AUX2);
            const int t = rb * 16 + fr;
#pragma unroll 2
            for (int c16 = 0; c16 < 16; ++c16) {
                const int ct = chh * 16 + c16;
                bf16x8_l bw[2], ba[2], bg[4];
#pragma unroll
                for (int ks = 0; ks < 2; ++ks) { bw[ks] = *(const bf16x8_l*)(W3F + ((size_t)(ct * 2 + ks) * 64 + F.lane) * 8); ba[ks] = *(const bf16x8_l*)(W3F + ((size_t)(64 + ct * 2 + ks) * 64 + F.lane) * 8); }
#pragma unroll
                for (int ks = 0; ks < 4; ++ks) bg[ks] = *(const bf16x8_l*)(W3F + ((size_t)(128 + ct * 4 + ks) * 64 + F.lane) * 8);
                f32x4 xw = {0.f, 0.f, 0.f, 0.f}, xa = xw, xg = xw;
#pragma unroll
                for (int ks = 0; ks < 2; ++ks) { xw = __builtin_amdgcn_mfma_f32_16x16x32_bf16(bw[ks], af[ks], xw, 0, 0, 0); xa = __builtin_amdgcn_mfma_f32_16x16x32_bf16(ba[ks], af[2 + ks], xa, 0, 0, 0); }
#pragma unroll
                for (int ks = 0; ks < 4; ++ks) xg = __builtin_amdgcn_mfma_f32_16x16x32_bf16(bg[ks], af[4 + ks], xg, 0, 0, 0);
                const int c0 = ct * 16 + 4 * fq;
                const f32x4 b0 = *(const f32x4*)(A.in[I_DECBASE] + c0), b1 = *(const f32x4*)(A.in[I_ABASE] + c0);
                f32x4 lam, aa;
#pragma unroll
                for (int i = 0; i < 4; ++i) { lam[i] = 0.6065306597126334f * sigmoid_f(b0[i] + xw[i]); aa[i] = sigmoid_f(b1[i] + xa[i]); }
                v2u o; o.x = pk2(lam[0], lam[1]); o.y = pk2(lam[2], lam[3]); *(v2u*)(LAMg + (size_t)(m0 + t) * 512 + c0) = o;
                o.x = pk2(aa[0], aa[1]); o.y = pk2(aa[2], aa[3]); *(v2u*)(AAg + (size_t)(m0 + t) * 512 + c0) = o;
                o.x = pk2(xg[0], xg[1]); o.y = pk2(xg[2], xg[3]);
                *(v2u*)(GGg + ((size_t)it * 8 + (ct >> 2)) * 4096 + ((rb * 4 + (ct & 3)) * 64 + F.lane) * 4) = o;
            }
        }
    }
}
template <int CTRL> __device__ __forceinline__ float dpp_f(float x) { return __builtin_bit_cast(float, __builtin_amdgcn_update_dpp(0, __builtin_bit_cast(int, x), CTRL, 0xF, 0xF, true)); }
__device__ __forceinline__ float dsum8(float v) { v += dpp_f<0xB1>(v); v += dpp_f<0x4E>(v); v += dpp_f<0x141>(v); return v; }
__device__ __forceinline__ float dsum16(float v) { v = dsum8(v); v += dpp_f<0x140>(v); return v; }
typedef short bf16x8_t __attribute__((ext_vector_type(8)));
constexpr int LDP = 72;
constexpr int LDF = 68;
constexpr int PA_TS = 0;
constexpr int PA_B0 = 65536, PA_BSZ = 64 * LDP * 2;
constexpr int PA_GC = PA_B0 + 10 * PA_BSZ, PA_BON = PA_GC + 256, PA_END = PA_BON + 256;
static_assert(PA_END <= MISC_OFF, "phase A LDS map");
#define PA_BUF(i) (PA_B0 + (i) * PA_BSZ)
__device__ __forceinline__ bf16x8_t ld8(const LAS bf16* p) { return *(const LAS bf16x8_t*)p; }
__device__ __forceinline__ bf16x8_t ld8(const bf16* p) { return *(const bf16x8_t*)p; }
struct MmPos { int rb, cb, fr, fq; };
template <int K, bool SWAP, typename PX, typename PY>
__device__ __forceinline__ void mm_nt(PX X, int ldx, PY Yt, int ldy, const MmPos& p, f32x4 (&acc)[2]) {
    const unsigned xo = (unsigned)((p.rb * 16 + p.fr) * ldx + p.fq * 8), yo = (unsigned)((p.cb + p.fr) * ldy + p.fq * 8);
#pragma unroll
    for (int ks = 0; ks < K / 32; ++ks) {
        const bf16x8_t a = ld8(X + (xo + ks * 32));
#pragma unroll
        for (int n = 0; n < 2; ++n) { const bf16x8_t b = ld8(Yt + (yo + (unsigned)(n * 16 * ldy + ks * 32)));
            acc[n] = SWAP ? __builtin_amdgcn_mfma_f32_16x16x32_bf16(b, a, acc[n], 0, 0, 0) : __builtin_amdgcn_mfma_f32_16x16x32_bf16(a, b, acc[n], 0, 0, 0); }
    }
}
__device__ __forceinline__ v2u pack4(const f32x4& v) { v2u o; o.x = pk2(v.x, v.y); o.y = pk2(v.z, v.w); return o; }
__device__ __forceinline__ void zero2(f32x4 (&a)[2]) { a[0] = (f32x4){0.f, 0.f, 0.f, 0.f}; a[1] = a[0]; }
#define PA_SYNC() __syncthreads()

constexpr int PA_WTOT = PA_BON + 256;
static_assert(PA_WTOT + 2048 <= MISC_OFF, "phase A LDS map");
struct HeadIn { unsigned short rz[9], kz[9], vz[9], lam[8], aa[8]; float cst[6]; };
__device__ __forceinline__ void pa_load(HeadIn& in, const Args& A, int m0, int h, int t8, int c, bool halo) {
    asm volatile("" : "+s"(t8));
    const bf16* ZR = (const bf16*)(A.ws + WS_ZR); const bf16* LAM = (const bf16*)(A.ws + WS_AUX0); const bf16* AAg = (const bf16*)(A.ws + WS_AUX1);
    const int hcc = h * HD + c;
    const bf16* zb = ZR + ((size_t)(m0 + t8) - 1) * LDZR + hcc;
    in.rz[0] = halo ? zb[0] : (unsigned short)0; in.kz[0] = halo ? zb[512] : (unsigned short)0; in.vz[0] = halo ? zb[1024] : (unsigned short)0;
#pragma unroll
    for (int j = 1; j < 9; ++j) { in.rz[j] = zb[(size_t)j * LDZR]; in.kz[j] = zb[(size_t)j * LDZR + 512]; in.vz[j] = zb[(size_t)j * LDZR + 1024]; }
#pragma unroll
    for (int i = 0; i < 8; ++i) { in.lam[i] = LAM[(size_t)(m0 + t8 + i) * 512 + hcc]; in.aa[i] = AAg[(size_t)(m0 + t8 + i) * 512 + hcc]; }
    in.cst[0] = A.in[I_MU][hcc]; in.cst[1] = A.in[I_MU][512 + hcc]; in.cst[2] = A.in[I_MU][1024 + hcc]; in.cst[3] = A.in[I_KK][hcc]; in.cst[4] = A.in[I_KA][hcc]; in.cst[5] = A.in[I_RK][hcc];
}
template <bool FULL>
__device__ __forceinline__ void pa_prep(const Frame& F, const HeadIn& in, int c, int t8) {
    LAS unsigned char* L = F.lds;
    LAS float* WTOT = (LAS float*)(L + PA_WTOT);
    float l[8];
    l[0] = bf2f(in.lam[0]);
#pragma unroll
    for (int i = 1; i < 8; ++i) l[i] = l[i - 1] + bf2f(in.lam[i]);
    WTOT[F.wave * 64 + c] = l[7];
    PA_SYNC();
    float off = 0.f;
#pragma unroll
    for (int w = 0; w < 7; ++w) off += (w < F.wave) ? WTOT[w * 64 + c] : 0.f;
    const float mur = in.cst[0], muk = in.cst[1], muv = in.cst[2], ckk = in.cst[3], cka = in.cst[4], crk = in.cst[5];
    LAS bf16* KAP = (LAS bf16*)(L + PA_BUF(0)); LAS bf16* BH = (LAS bf16*)(L + PA_BUF(1)); LAS bf16* KH = (LAS bf16*)(L + PA_BUF(2)); LAS bf16* RH = (LAS bf16*)(L + PA_BUF(3));
    float bh8[8], kh8[8], v8[8], kap8[8];
#pragma unroll
    for (int i = 0; i < 8; ++i) {
        const int t = t8 + i; const float aq = bf2f(in.aa[i]);
        const float r0 = bf2f(in.rz[i + 1]), k0 = bf2f(in.kz[i + 1]), v0 = bf2f(in.vz[i + 1]);
        const float rr = r0 + (bf2f(in.rz[i]) - r0) * mur, kk = k0 + (bf2f(in.kz[i]) - k0) * muk, vv = v0 + (bf2f(in.vz[i]) - v0) * muv;
        const float kkn = kk * ckk, kpm = kk * (1.0f + (aq - 1.0f) * cka);
        float ss = dsum16(kkn * kkn), bd = 0.f;
        ss += __shfl_xor(ss, 16); ss += __shfl_xor(ss, 32);
        if (FULL) { bd = dsum16(rr * kpm * crk); bd += __shfl_xor(bd, 16); bd += __shfl_xor(bd, 32); }
        const float lgt = off + l[i], lgp = (i > 0) ? off + l[i - 1] : off;
        const float kkq = kkn * __builtin_amdgcn_rsqf(fmaxf(ss, 1e-24f)), gi = __expf(lgt);
        const float kapv = __expf(-lgp) * kkq, bhv = kkq * aq * gi, khv = kpm * gi, rhv = __expf(-lgt) * rr;
        v8[i] = vv; kap8[i] = kapv; bh8[i] = bhv; kh8[i] = khv;
        KAP[t * LDP + c] = (bf16)f2bf(kapv); BH[t * LDP + c] = (bf16)f2bf(bhv);
        if (FULL) { KH[t * LDP + c] = (bf16)f2bf(khv); RH[t * LDP + c] = (bf16)f2bf(rhv); if (c == 0) ((LAS float*)(L + PA_BON))[t] = bd; }
    }
    if (FULL) {
        LAS bf16* BHT = (LAS bf16*)(L + PA_BUF(4)); LAS bf16* KHT = (LAS bf16*)(L + PA_BUF(5)); LAS bf16* VT = (LAS bf16*)(L + PA_BUF(6)); LAS bf16* KAPT = (LAS bf16*)(L + PA_BUF(7));
        { v4u o; o.x = pk2(bh8[0], bh8[1]); o.y = pk2(bh8[2], bh8[3]); o.z = pk2(bh8[4], bh8[5]); o.w = pk2(bh8[6], bh8[7]); *(LAS v4u*)(BHT + c * LDP + t8) = o; }
        { v4u o; o.x = pk2(kh8[0], kh8[1]); o.y = pk2(kh8[2], kh8[3]); o.z = pk2(kh8[4], kh8[5]); o.w = pk2(kh8[6], kh8[7]); *(LAS v4u*)(KHT + c * LDP + t8) = o; }
        { v4u o; o.x = pk2(v8[0], v8[1]); o.y = pk2(v8[2], v8[3]); o.z = pk2(v8[4], v8[5]); o.w = pk2(v8[6], v8[7]); *(LAS v4u*)(VT + c * LDP + t8) = o; }
        { v4u o; o.x = pk2(kap8[0], kap8[1]); o.y = pk2(kap8[2], kap8[3]); o.z = pk2(kap8[4], kap8[5]); o.w = pk2(kap8[6], kap8[7]); *(LAS v4u*)(KAPT + c * LDP + t8) = o; }
        if (F.wave == 7) ((LAS float*)(L + PA_GC))[c] = __expf(-(off + l[7]));
    }
}

template <int T0> __device__ __forceinline__ void pa_solve_row(const LAS bf16* Ts, int lane, float (&X)[64]) {
    int lv = lane; asm volatile("" : "+v"(lv));
    float acc = (lv == T0) ? 1.f : 0.f;
#pragma clang loop unroll(full)
    for (int i8 = 0; i8 < (T0 + 7) / 8; ++i8) {
        const v4u raw = *(const LAS v4u*)(Ts + T0 * 64 + i8 * 8);
#pragma clang loop unroll(full)
        for (int e = 0; e < 8; ++e) { const int i = i8 * 8 + e; if (i < T0) { const unsigned w = raw[e >> 1]; acc -= ((e & 1) ? bfhi(w) : bflo(w)) * X[i]; } }
    }
    X[T0] = acc;
    asm volatile("" ::: "memory");
}
template <int T0> struct PaSolveRows { static __device__ __forceinline__ void run(const LAS bf16* Ts, int lane, float (&X)[64]) { PaSolveRows<T0 - 1>::run(Ts, lane, X); pa_solve_row<T0>(Ts, lane, X); } };
template <> struct PaSolveRows<-1> { static __device__ __forceinline__ void run(const LAS bf16*, int, float (&)[64]) {} };
__device__ __forceinline__ void pa_solve_T(LAS bf16* Ts, int lane) {
    float X[64];
    PaSolveRows<63>::run(Ts, lane, X);
#pragma clang loop unroll(full)
    for (int t = 0; t < 64; ++t) Ts[t * 64 + lane] = (bf16)f2bf(X[t]);
}

__device__ __forceinline__ void pa_step1(const Frame& F, const HeadIn& in, int h, int c, int t8, const MmPos& p) {
    asm volatile("" : "+s"(t8));
    LAS unsigned char* L = F.lds;
    PB(3); pa_prep<false>(F, in, c, t8); PA_SYNC(); PE(3);
    PB(4);
    f32x4 ab[2]; zero2(ab);
    mm_nt<64, true>((const LAS bf16*)(L + PA_BUF(0)), LDP, (const LAS bf16*)(L + PA_BUF(1)), LDP, p, ab);
    LAS bf16* Ts = (LAS bf16*)(L + PA_TS + h * 8192);
#pragma unroll
    for (int n = 0; n < 2; ++n) { const int t = p.rb * 16 + p.fr, j0 = p.cb + n * 16 + 4 * p.fq; f32x4 v = ab[n];
#pragma unroll
        for (int i = 0; i < 4; ++i) v[i] = (j0 + i < t) ? v[i] : 0.f;
        *(LAS v2u*)(Ts + t * 64 + j0) = pack4(v); }
    PA_SYNC();
    PE(4);
}
__device__ __forceinline__ void pa_step2(const Frame& F, const Args& A, const HeadIn& in, int item, int h, int c, int t8, const MmPos& p) {
    asm volatile("" : "+s"(t8));
    LAS unsigned char* L = F.lds;
    bf16* PHT = (bf16*)(A.ws + WS_PHT); bf16* PSI = (bf16*)(A.ws + WS_PSI); bf16* QQ = (bf16*)(A.ws + WS_QQ); bf16* PP = (bf16*)(A.ws + WS_PP); bf16* G2 = (bf16*)(A.ws + WS_G2);
    const size_t ch = ((size_t)item * HEADS + h) * 4096;
    PB(3); pa_prep<true>(F, in, c, t8); PA_SYNC(); PE(3);
    PB(6);
    const LAS bf16* KAP = (const LAS bf16*)(L + PA_BUF(0)); const LAS bf16* BH = (const LAS bf16*)(L + PA_BUF(1)); const LAS bf16* KH = (const LAS bf16*)(L + PA_BUF(2)); const LAS bf16* RH = (const LAS bf16*)(L + PA_BUF(3));
    const LAS bf16* BHT = (const LAS bf16*)(L + PA_BUF(4)); const LAS bf16* KHT = (const LAS bf16*)(L + PA_BUF(5)); const LAS bf16* VT = (const LAS bf16*)(L + PA_BUF(6)); const LAS bf16* KAPT = (const LAS bf16*)(L + PA_BUF(7));
    LAS bf16* ARB = (LAS bf16*)(L + PA_BUF(8)); LAS bf16* ARK = (LAS bf16*)(L + PA_BUF(9));
    LAS bf16* AK = (LAS bf16*)(L + PA_BUF(0)); LAS bf16* YT = (LAS bf16*)(L + PA_BUF(1)); LAS bf16* WT = (LAS bf16*)(L + PA_BUF(2)); LAS bf16* UT = (LAS bf16*)(L + PA_BUF(0));
    const LAS bf16* Ts = (const LAS bf16*)(L + PA_TS + h * 8192);
    const int tt = p.rb * 16 + p.fr;
    {
        f32x4 arb[2], ark[2], ak[2]; zero2(arb); zero2(ark); zero2(ak);
        mm_nt<64, true>(RH, LDP, BH, LDP, p, arb); mm_nt<64, true>(RH, LDP, KH, LDP, p, ark); mm_nt<64, true>(KAP, LDP, KH, LDP, p, ak);
#pragma unroll
        for (int n = 0; n < 2; ++n) { const int j0 = p.cb + n * 16 + 4 * p.fq;
#pragma unroll
            for (int i = 0; i < 4; ++i) { const bool le = (j0 + i <= tt), lt = (j0 + i < tt); arb[n][i] = le ? arb[n][i] : 0.f; ark[n][i] = le ? ark[n][i] : 0.f; ak[n][i] = lt ? ak[n][i] : 0.f; }
            *(LAS v2u*)(ARB + tt * LDP + j0) = pack4(arb[n]); *(LAS v2u*)(ARK + tt * LDP + j0) = pack4(ark[n]); }
        PA_SYNC();
#pragma unroll
        for (int n = 0; n < 2; ++n) *(LAS v2u*)(AK + tt * LDP + p.cb + n * 16 + 4 * p.fq) = pack4(ak[n]);
    }
    PA_SYNC();
    PE(6); PB(7);
    {
        f32x4 y[2]; zero2(y);
        mm_nt<64, false>((const LAS bf16*)AK, LDP, VT, LDP, p, y);
#pragma unroll
        for (int n = 0; n < 2; ++n) *(LAS v2u*)(YT + (p.cb + n * 16 + p.fr) * LDP + p.rb * 16 + 4 * p.fq) = pack4(y[n]);
    }
    PA_SYNC();
    {
        f32x4 w[2], u[2]; zero2(w); zero2(u);
        mm_nt<64, false>(Ts, 64, KAPT, LDP, p, w); mm_nt<64, false>(Ts, 64, (const LAS bf16*)YT, LDP, p, u);
#pragma unroll
        for (int n = 0; n < 2; ++n) { *(LAS v2u*)(WT + (p.cb + n * 16 + p.fr) * LDP + p.rb * 16 + 4 * p.fq) = pack4(w[n]); *(LAS v2u*)(UT + (p.cb + n * 16 + p.fr) * LDP + p.rb * 16 + 4 * p.fq) = pack4(u[n]); }
    }
    PA_SYNC();
    PE(7); PB(8);
    {
        f32x4 q[2], pa[2], pb[2]; zero2(q); zero2(pa); zero2(pb);
        mm_nt<64, true>((const LAS bf16*)ARB, LDP, (const LAS bf16*)WT, LDP, p, q); mm_nt<64, true>((const LAS bf16*)ARK, LDP, VT, LDP, p, pa); mm_nt<64, true>((const LAS bf16*)ARB, LDP, (const LAS bf16*)UT, LDP, p, pb);
#pragma unroll
        for (int n = 0; n < 2; ++n) { const int c0 = p.cb + n * 16 + 4 * p.fq; const v2u rw = *(const LAS v2u*)(RH + tt * LDP + c0);
            f32x4 qv; qv.x = bflo(rw.x) - q[n].x; qv.y = bfhi(rw.x) - q[n].y; qv.z = bflo(rw.y) - q[n].z; qv.w = bfhi(rw.y) - q[n].w;
            *(v2u*)(QQ + ch + ((p.rb * 2 + (p.cb >> 5)) * 64 + (n * 2 + (p.fq >> 1)) * 16 + p.fr) * 8 + 4 * (p.fq & 1)) = pack4(qv);
            *(v2u*)(PP + ch + ((p.rb * 4 + (p.cb >> 4) + n) * 64 + p.fq * 16 + p.fr) * 4) = pack4(pa[n] - pb[n]); }
    }
    {
        f32x4 cc[2]; zero2(cc);
        mm_nt<64, false>((const LAS bf16*)WT, LDP, BHT, LDP, p, cc);
#pragma unroll
        for (int n = 0; n < 2; ++n) { const int k2 = p.cb + n * 16 + p.fr, k1 = p.rb * 16 + 4 * p.fq; const float gc = ((const LAS float*)(L + PA_GC))[k2]; f32x4 v;
#pragma unroll
            for (int i = 0; i < 4; ++i) v[i] = (((k1 + i) == k2 ? 1.f : 0.f) - cc[n][i]) * gc;
            *(v2u*)(PHT + ch + (((k2 >> 4) * 2 + (k1 >> 5)) * 64 + ((k1 & 31) >> 3) * 16 + (k2 & 15)) * 8 + (k1 & 7)) = pack4(v); }
    }
    {
        f32x4 sa[2], sb[2]; zero2(sa); zero2(sb);
        mm_nt<64, true>(VT, LDP, KHT, LDP, p, sa); mm_nt<64, true>((const LAS bf16*)UT, LDP, BHT, LDP, p, sb);
#pragma unroll
        for (int n = 0; n < 2; ++n) { const int k0 = p.cb + n * 16 + 4 * p.fq; const f32x4 gc = *(const LAS f32x4*)((const LAS float*)(L + PA_GC) + k0);
            *(v2u*)(PSI + ch + ((p.rb * 4 + (p.cb >> 4) + n) * 64 + p.fq * 16 + p.fr) * 4) = pack4((sa[n] - sb[n]) * gc); }
    }
    {
        const float bon = ((const LAS float*)(L + PA_BON))[tt];
#pragma unroll
        for (int n = 0; n < 2; ++n) { const int v0 = p.cb + n * 16 + 4 * p.fq; const f32x4 lb = *(const f32x4*)(A.in[I_LNB] + h * HD + v0);
            f32x4 vv;
#pragma unroll
            for (int i = 0; i < 4; ++i) vv[i] = bf2f(VT[(v0 + i) * LDP + tt]);
            *(v2u*)(G2 + ch + ((p.rb * 4 + (p.cb >> 4) + n) * 64 + p.fq * 16 + p.fr) * 4) = pack4(lb + bon * vv); }
    }
    PA_SYNC();
    PE(8);
}
__device__ __forceinline__ void pa_phase(const Frame& F, const Args& A) {
    LAS unsigned char* L = F.lds;
    for (int item = blockIdx.x; item < BATCH * (SEQ / 64); item += F.G) {
        const int b = item / (SEQ / 64), chunk = item % (SEQ / 64), m0 = b * SEQ + chunk * 64;
        int tidv = F.tid; asm volatile("" : "+v"(tidv));
        const int c = tidv & 63, t8 = F.wave * 8; const bool halo = chunk > 0 || t8 > 0;
        MmPos p; p.rb = F.wave >> 1; p.cb = (F.wave & 1) * 32; p.fr = tidv & 15; p.fq = (tidv >> 4) & 3;
        HeadIn cur, nxt;
        pa_load(cur, A, m0, 0, t8, c, halo);
#pragma unroll 1
        for (int h = 0; h < HEADS; ++h) {
            pa_load(nxt, A, m0, (h + 1) & 7, t8, c, halo);
            pa_step1(F, cur, h, c, t8, p);
            cur = nxt;
        }
        PB(5);
        { int lanev = F.lane; asm volatile("" : "+v"(lanev)); pa_solve_T((LAS bf16*)(L + PA_TS + F.wave * 8192), lanev); }
        PA_SYNC();
        PE(5);
#pragma unroll 1
        for (int h = 0; h < HEADS; ++h) {
            pa_load(nxt, A, m0, (h + 1) & 7, t8, c, halo);
            pa_step2(F, A, cur, item, h, c, t8, p);
            cur = nxt;
        }
    }
}

struct ScanOps { bf16x8_t b[4][2]; v2u psi[4]; };
__device__ __forceinline__ void ps_load(ScanOps& o, const bf16* PHT, const bf16* PSI, size_t ch, int tt, int fr, int fq) {
#pragma unroll
    for (int n = 0; n < 4; ++n) { o.psi[n] = *(const v2u*)(PSI + ch + (((tt >> 4) * 4 + n) * 64 + fq * 16 + fr) * 4);
#pragma unroll
        for (int ks = 0; ks < 2; ++ks) o.b[n][ks] = *(const bf16x8_t*)(PHT + ch + ((n * 2 + ks) * 64 + fq * 16 + fr) * 8); }
}
__device__ __forceinline__ void ps_scan(const Frame& F, const Args& A, int item) {
    LAS unsigned char* L = F.lds;
    const int fr = F.lane & 15, fq = F.lane >> 4, tt = (F.wave & 3) * 16 + fr;
    const bf16* PHT = (const bf16*)(A.ws + WS_PHT); const bf16* PSI = (const bf16*)(A.ws + WS_PSI); bf16* SST = (bf16*)A.out;
    const int b = item >> 3, h = item & 7;
    const size_t ch0 = ((size_t)(b * (SEQ / 64)) * HEADS + h) * 4096, cstep = (size_t)HEADS * 4096;
    if (F.wave < 4) {
        f32x4 s[4];
#pragma unroll
        for (int n = 0; n < 4; ++n) s[n] = (f32x4){0.f, 0.f, 0.f, 0.f};
        ScanOps oa, ob;
        ps_load(oa, PHT, PSI, ch0, tt, fr, fq);
#pragma unroll 1
        for (int c = 0; c < SEQ / 64; c += 2) {
#pragma unroll
            for (int u = 0; u < 2; ++u) {
                ScanOps& cur = u ? ob : oa; ScanOps& nxt = u ? oa : ob;
                const int cn = (c + u + 1 < SEQ / 64) ? c + u + 1 : c + u;
                ps_load(nxt, PHT, PSI, ch0 + (size_t)cn * cstep, tt, fr, fq);
                LAS bf16* SB = (LAS bf16*)(L + u * PA_BSZ);
#pragma unroll
                for (int n = 0; n < 4; ++n) *(LAS v2u*)(SB + tt * LDP + n * 16 + 4 * fq) = pack4(s[n]);
                asm volatile("s_waitcnt lgkmcnt(0)" ::: "memory"); __builtin_amdgcn_s_barrier(); asm volatile("" ::: "memory");
                f32x4 acc[4];
#pragma unroll
                for (int n = 0; n < 4; ++n) acc[n] = (f32x4){0.f, 0.f, 0.f, 0.f};
#pragma unroll
                for (int ks = 0; ks < 2; ++ks) { const bf16x8_t a = *(const LAS bf16x8_t*)(SB + tt * LDP + ks * 32 + fq * 8);
#pragma unroll
                    for (int n = 0; n < 4; ++n) acc[n] = __builtin_amdgcn_mfma_f32_16x16x32_bf16(cur.b[n][ks], a, acc[n], 0, 0, 0); }
#pragma unroll
                for (int n = 0; n < 4; ++n) { s[n].x = acc[n].x + bflo(cur.psi[n].x); s[n].y = acc[n].y + bfhi(cur.psi[n].x); s[n].z = acc[n].z + bflo(cur.psi[n].y); s[n].w = acc[n].w + bfhi(cur.psi[n].y); }
            }
        }
    } else {
        const int w4 = F.wave - 4;
#pragma unroll 1
        for (int c = 0; c < SEQ / 64; ++c) {
            const LAS bf16* SB = (const LAS bf16*)(L + (c & 1) * PA_BSZ);
            asm volatile("s_waitcnt lgkmcnt(0)" ::: "memory"); __builtin_amdgcn_s_barrier(); asm volatile("" ::: "memory");
            const v4u x0 = *(const LAS v4u*)(SB + (w4 * 16 + fr) * LDP + fq * 8), x1 = *(const LAS v4u*)(SB + (w4 * 16 + fr) * LDP + 32 + fq * 8);
            bf16* dst = SST + ch0 + (size_t)c * cstep + ((w4 * 2) * 64 + fq * 16 + fr) * 8;
            *(v4u*)dst = x0; *(v4u*)(dst + 512) = x1;
        }
    }
}

__device__ __forceinline__ void pc_phase(const Frame& F, const Args& A) {
    const bf16* QQ = (const bf16*)(A.ws + WS_QQ); const bf16* PP = (const bf16*)(A.ws + WS_PP); const bf16* GG = (const bf16*)(A.ws + WS_AUX2); const bf16* G2 = (const bf16*)(A.ws + WS_G2);
    const bf16* SST = (const bf16*)A.out; bf16* Y = (bf16*)(A.ws + WS_Y);
    const int fr = F.lane & 15, fq = F.lane >> 4, rbk = F.wave & 3;
    for (int item = blockIdx.x; item < BATCH * (SEQ / 64); item += F.G) {
        const int b = item / (SEQ / 64), chunk = item % (SEQ / 64), m0 = b * SEQ + chunk * 64, tt = rbk * 16 + fr;
#pragma unroll 1
        for (int hp = 0; hp < 4; ++hp) {
            const int h = hp * 2 + (F.wave >> 2); const size_t ch = ((size_t)item * HEADS + h) * 4096;
            f32x4 o[4];
#pragma unroll
            for (int n = 0; n < 4; ++n) o[n] = (f32x4){0.f, 0.f, 0.f, 0.f};
#pragma unroll
            for (int ks = 0; ks < 2; ++ks) { const bf16x8_t a = *(const bf16x8_t*)(QQ + ch + ((rbk * 2 + ks) * 64 + fq * 16 + fr) * 8);
#pragma unroll
                for (int n = 0; n < 4; ++n) { const bf16x8_t bb = *(const bf16x8_t*)(SST + ch + ((n * 2 + ks) * 64 + fq * 16 + fr) * 8); o[n] = __builtin_amdgcn_mfma_f32_16x16x32_bf16(bb, a, o[n], 0, 0, 0); } }
            float sum = 0.f;
#pragma unroll
            for (int n = 0; n < 4; ++n) { const v2u pw = *(const v2u*)(PP + ch + ((rbk * 4 + n) * 64 + fq * 16 + fr) * 4); o[n].x += bflo(pw.x); o[n].y += bfhi(pw.x); o[n].z += bflo(pw.y); o[n].w += bfhi(pw.y); sum += (o[n].x + o[n].y) + (o[n].z + o[n].w); }
            sum += __shfl_xor(sum, 16); sum += __shfl_xor(sum, 32);
            const float mean = sum * (1.f / 64.f); float var = 0.f;
#pragma unroll
            for (int n = 0; n < 4; ++n) { o[n] = o[n] - mean; var += (o[n].x * o[n].x + o[n].y * o[n].y) + (o[n].z * o[n].z + o[n].w * o[n].w); }
            var += __shfl_xor(var, 16); var += __shfl_xor(var, 32);
            const float rstd = rsqrtf(var * (1.f / 64.f) + LN_X_EPS);
#pragma unroll
            for (int n = 0; n < 4; ++n) { const unsigned ao = ((rbk * 4 + n) * 64 + fq * 16 + fr) * 4; const v2u gg = *(const v2u*)(GG + ch + ao), g2 = *(const v2u*)(G2 + ch + ao);
                const f32x4 lw = *(const f32x4*)(A.in[I_LNW] + h * HD + n * 16 + 4 * fq); f32x4 y;
                y.x = (o[n].x * rstd * lw.x + bflo(g2.x)) * bflo(gg.x); y.y = (o[n].y * rstd * lw.y + bfhi(g2.x)) * bfhi(gg.x); y.z = (o[n].z * rstd * lw.z + bflo(g2.y)) * bflo(gg.y); y.w = (o[n].w * rstd * lw.w + bfhi(g2.y)) * bfhi(gg.y);
                *(v2u*)(Y + (size_t)(m0 + tt) * D + DCONV + h * HD + n * 16 + 4 * fq) = pack4(y); }
        }
    }
}
constexpr int RT_LD = 264;
__device__ __forceinline__ void p5_router(const Frame& F, const Args& A, bool commit) {
    typedef short bf16x8_r __attribute__((ext_vector_type(8)));
    const float* H1 = A.out; const bf16* WRH = (const bf16*)(A.ws + WS_WRT); const bf16* WRL = WRH + 3 * 32 * 64 * 8;
    int* tok_e = (int*)(A.ws + WS_TOK); int* tok_r0 = tok_e + M; int* tok_r1 = tok_e + 2 * M; float* tok_g0 = (float*)(tok_e + 3 * M); float* tok_g1 = (float*)(tok_e + 4 * M); float* tok_rs = (float*)(tok_e + 5 * M);
    LAS bf16* UH = (LAS bf16*)F.lds; LAS bf16* UL = UH + 64 * RT_LD;
    LAS float* LOG = (LAS float*)(F.lds + 69632);
    LAS float* RS = (LAS float*)(F.lds + 69632 + 2 * 64 * 48 * 4);
    LAS bf16* WSL = (LAS bf16*)(F.lds + 98304);
    const int fr = F.lane & 15, fq = F.lane >> 4, rt = F.wave & 3, kh = F.wave >> 2;
    for (int tile = blockIdx.x; tile < M / 64; tile += F.G) {
        const int mw = tile * 64 + F.wave * 8;
        f32x4 va[8], vb[8];
#pragma unroll
        for (int r = 0; r < 8; ++r) va[r] = *((const f32x4*)(H1 + (size_t)(mw + r) * D) + F.lane);
        v4u wpre[6];
#pragma unroll
        for (int pc = 0; pc < 6; ++pc) wpre[pc] = *(const v4u*)((pc < 3 ? WRH : WRL) + ((size_t)((pc % 3) * 32 + 0) * 64) * 8 + F.tid * 8);
        f32x4 acc[3]; acc[0] = (f32x4){0.f, 0.f, 0.f, 0.f}; acc[1] = acc[0]; acc[2] = acc[0];
        float ssq[8];
#pragma unroll
        for (int r = 0; r < 8; ++r) ssq[r] = 0.f;
#pragma unroll 1
        for (int s2 = 0; s2 < 4; s2 += 2)
#pragma unroll
        for (int sp = 0; sp < 2; ++sp) { const int s = s2 + sp;
            f32x4 (&v)[8] = sp ? vb : va; f32x4 (&vn)[8] = sp ? va : vb;
            const f32x4 gf = *((const f32x4*)(A.in[I_GFFN] + s * 256) + F.lane);
            if (s < 3) {
#pragma unroll
                for (int r = 0; r < 8; ++r) vn[r] = *((const f32x4*)(H1 + (size_t)(mw + r) * D + (s + 1) * 256) + F.lane); }
            __syncthreads();
#pragma unroll
            for (int pc = 0; pc < 6; ++pc) *(LAS v4u*)(WSL + pc * 4096 + F.tid * 8) = wpre[pc];
            if (s < 3) {
#pragma unroll
                for (int pc = 0; pc < 6; ++pc) wpre[pc] = *(const v4u*)((pc < 3 ? WRH : WRL) + ((size_t)((pc % 3) * 32 + (s + 1) * 8) * 64) * 8 + F.tid * 8); }
#pragma unroll
            for (int r = 0; r < 8; ++r) { ssq[r] += (v[r].x * v[r].x + v[r].y * v[r].y) + (v[r].z * v[r].z + v[r].w * v[r].w);
                const f32x4 u = v[r] * gf; v2u hi; hi.x = pk2(u.x, u.y); hi.y = pk2(u.z, u.w);
                f32x4 lo; lo.x = u.x - bflo(hi.x); lo.y = u.y - bfhi(hi.x); lo.z = u.z - bflo(hi.y); lo.w = u.w - bfhi(hi.y);
                v2u lw; lw.x = pk2(lo.x, lo.y); lw.y = pk2(lo.z, lo.w);
                *(LAS v2u*)(UH + (F.wave * 8 + r) * RT_LD + F.lane * 4) = hi; *(LAS v2u*)(UL + (F.wave * 8 + r) * RT_LD + F.lane * 4) = lw; }
            __syncthreads();
#pragma unroll
            for (int q = 0; q < 4; ++q) { const int ksl = kh * 4 + q;
                const bf16x8_r ah = *(const LAS bf16x8_r*)(UH + (rt * 16 + fr) * RT_LD + ksl * 32 + fq * 8), al = *(const LAS bf16x8_r*)(UL + (rt * 16 + fr) * RT_LD + ksl * 32 + fq * 8);
#pragma unroll
                for (int nt = 0; nt < 3; ++nt) { const bf16x8_r bh = *(const LAS bf16x8_r*)(WSL + ((nt * 8 + ksl) * 64 + F.lane) * 8), bl = *(const LAS bf16x8_r*)(WSL + 12288 + ((nt * 8 + ksl) * 64 + F.lane) * 8);
                    acc[nt] = __builtin_amdgcn_mfma_f32_16x16x32_bf16(ah, bh, acc[nt], 0, 0, 0); acc[nt] = __builtin_amdgcn_mfma_f32_16x16x32_bf16(ah, bl, acc[nt], 0, 0, 0); acc[nt] = __builtin_amdgcn_mfma_f32_16x16x32_bf16(al, bh, acc[nt], 0, 0, 0); } }
        }
#pragma unroll
        for (int nt = 0; nt < 3; ++nt)
#pragma unroll
            for (int i = 0; i < 4; ++i) LOG[(kh * 64 + rt * 16 + 4 * fq + i) * 48 + nt * 16 + fr] = acc[nt][i];
#pragma unroll
        for (int r = 0; r < 8; ++r) { const float t = wave_sum(ssq[r]); if (F.lane == 0) RS[F.wave * 8 + r] = rsqrtf(t * (1.f / D) + RMS_EPS); }
        __syncthreads();
        {
            bf16* HN = (bf16*)(A.ws + WS_HN);
#pragma unroll 1
            for (int qp = 0; qp < 4; ++qp) {
                f32x4 hv[2][4];
#pragma unroll
                for (int r = 0; r < 2; ++r)
#pragma unroll
                    for (int j = 0; j < 4; ++j) hv[r][j] = *((const f32x4*)(H1 + (size_t)(mw + qp * 2 + r) * D) + F.lane + 64 * j);
                asm volatile("" ::: "memory");
#pragma unroll
                for (int r = 0; r < 2; ++r) { const float rs = RS[F.wave * 8 + qp * 2 + r]; v2u* o8 = (v2u*)(HN + (size_t)(mw + qp * 2 + r) * D) + F.lane;
#pragma unroll
                    for (int j = 0; j < 4; ++j) { const f32x4 u = hv[r][j] * rs * *((const f32x4*)A.in[I_GFFN] + F.lane + 64 * j); v2u o; o.x = pk2(u.x, u.y); o.y = pk2(u.z, u.w); o8[64 * j] = o; } }
            }
        }
        if (F.tid < 64) {
            const int m = tile * 64 + F.tid; const float rs = RS[F.tid];
            float lg[36];
#pragma unroll
            for (int n = 0; n < 36; ++n) lg[n] = (LOG[F.tid * 48 + n] + LOG[(64 + F.tid) * 48 + n]) * rs;
#pragma unroll
        for (int n = 0; n < NG; ++n) lg[n] += A.in[I_RGB][n];
#pragma unroll
        for (int n = 0; n < NE; ++n) lg[NG + n] += A.in[I_REB][n];
        float gmax = lg[0]; int gi = 0;
#pragma unroll
        for (int j = 1; j < NG; ++j) if (lg[j] > gmax) { gmax = lg[j]; gi = j; }
        float gsum = 0.f;
#pragma unroll
        for (int j = 0; j < NG; ++j) gsum += __expf(lg[j] - gmax);
        const float gprob = 1.0f / gsum;
        float ig[EPG];
#pragma unroll
        for (int j = 0; j < EPG; ++j) ig[j] = (gi == 0) ? lg[NG + j] : ((gi == 1) ? lg[NG + 8 + j] : ((gi == 2) ? lg[NG + 16 + j] : lg[NG + 24 + j]));
        float l0 = ig[0]; int i0 = 0;
#pragma unroll
        for (int j = 1; j < EPG; ++j) if (ig[j] > l0) { l0 = ig[j]; i0 = j; }
        float l1 = -3.0e38f; int i1 = 0;
#pragma unroll
        for (int j = 0; j < EPG; ++j) if (j != i0 && ig[j] > l1) { l1 = ig[j]; i1 = j; }
        const float p0 = 1.0f / (1.0f + __expf(l1 - l0)), p1 = 1.0f - p0;
        const int e0 = gi * EPG + i0, e1 = gi * EPG + i1;
        LAS unsigned* HIST = (LAS unsigned*)(F.lds + 69632 + 2 * 64 * 48 * 4 + 256);
        if (F.tid < 32) HIST[F.tid] = 0u;
        asm volatile("s_waitcnt lgkmcnt(0)" ::: "memory");
        const unsigned lr0 = __hip_atomic_fetch_add(&HIST[e0], 1u, __ATOMIC_RELAXED, __HIP_MEMORY_SCOPE_WORKGROUP), l1r = __hip_atomic_fetch_add(&HIST[e1], 1u, __ATOMIC_RELAXED, __HIP_MEMORY_SCOPE_WORKGROUP);
        asm volatile("s_waitcnt lgkmcnt(0)" ::: "memory");
        if (F.tid < 32) { const unsigned cnt = HIST[F.tid]; HIST[32 + F.tid] = (commit && cnt) ? atomicAdd(F.ctl + CW_CNT + 64 * F.tid, cnt) : 0u; }
        asm volatile("s_waitcnt vmcnt(0) lgkmcnt(0)" ::: "memory");
        if (commit) {
            const int r0 = (int)(HIST[32 + e0] + lr0), r1 = (int)(HIST[32 + e1] + l1r);
            tok_e[m] = e0 | (e1 << 8); tok_r0[m] = r0; tok_r1[m] = r1; tok_g0[m] = gprob * p0; tok_g1[m] = gprob * p1; tok_rs[m] = rs;
            int* tokmap = (int*)(A.ws + WS_TOKMAP); tokmap[(e0 << 14) + r0] = m; tokmap[(e1 << 14) + r1] = m;
        }
        }
        __syncthreads();
    }
}
__device__ __forceinline__ void expert_convert(const Frame& F, const Args& A, int gw, int NGW) {
    LAS float* scr = (LAS float*)(F.lds + F.wave * 16384);
    bf16* WGU = (bf16*)(A.ws + WS_WGU); bf16* WDt = (bf16*)(A.ws + WS_WD);
    constexpr int IPE = (D / 64) * (DE / 32);
    for (int it = gw; it < 3 * NE * IPE; it += NGW) {
        const int which = it / (NE * IPE), r = it % (NE * IPE), e = r / IPE, q = r % IPE;
        if (which < 2) { const int kb = q / (DE / 32), nb = q % (DE / 32), n0 = 32 * nb;
            transpose_item(A.in[which == 0 ? I_EWG : I_EWU] + (size_t)e * D * DE, DE, 64 * kb, n0, WGU, D, e * 512 + 256 * (n0 >> 7) + (n0 & 127) + (which == 1 ? 128 : 0), scr, F.lane); }
        else { const int kb = q / (D / 32), nb = q % (D / 32);
            transpose_item(A.in[I_EWD] + (size_t)e * DE * D, D, 64 * kb, 32 * nb, WDt, DE, e * D + 32 * nb, scr, F.lane); }
    }
}
__device__ __forceinline__ void load_offsets(const Frame& F, const Args& A) {
    LAS int* offs = (LAS int*)(F.lds + OFFS_OFF);
    LAS int* tile_e = (LAS int*)(F.lds + TILEE_OFF);
    if (F.tid < 64) {
        const int e = F.lane & 31;
        const int c = (int)__hip_atomic_load(F.ctl + CW_CNT + 64 * e, __ATOMIC_RELAXED, __HIP_MEMORY_SCOPE_AGENT);
        const int padded = (c + 255) & ~255;
        int incl = padded;
#pragma unroll
        for (int d = 1; d < 32; d <<= 1) { const int up = __shfl_up(incl, d, 32); if (e >= d) incl += up; }
        const int o = incl - padded;
        if (F.lane < 32) { offs[e] = o; offs[40 + e] = c; if (e == 31) offs[NE] = incl;
            for (int t = o >> 8; t < (incl >> 8); ++t) tile_e[t] = e; }
    }
    __syncthreads();
}
__device__ __forceinline__ void p6a_gather(const Frame& F, const Args& A) {
    load_offsets(F, A);
    const LAS int* offs = (const LAS int*)(F.lds + OFFS_OFF);
    const int gw = blockIdx.x * NWAVES + F.wave, NGW = F.G * NWAVES;
    const float* H1 = A.out; bf16* XS = (bf16*)(A.ws + WS_XS);
    const int* tok_e = (const int*)(A.ws + WS_TOK); const int* tok_r0 = tok_e + M; const int* tok_r1 = tok_e + 2 * M; const float* tok_rs = (const float*)(tok_e + 5 * M);
    int* tok_s0 = (int*)(A.ws + WS_TOK) + 6 * M; int* tok_s1 = tok_s0 + M;
    const f32x4* gf4 = (const f32x4*)A.in[I_GFFN] + F.lane;
    for (int m = gw; m < M; m += NGW) {
        const int ee = tok_e[m], e0 = ee & 255, e1 = (ee >> 8) & 255;
        const int s0 = offs[e0] + tok_r0[m], s1 = offs[e1] + tok_r1[m];
        const float rs = tok_rs[m];
        const f32x4* hr = (const f32x4*)(H1 + (size_t)m * D) + F.lane;
        v2u* o0 = (v2u*)(XS + (size_t)s0 * D) + F.lane; v2u* o1 = (v2u*)(XS + (size_t)s1 * D) + F.lane;
#pragma unroll
        for (int j = 0; j < 4; ++j) { const f32x4 v = hr[64 * j] * rs * gf4[64 * j]; v2u o; o.x = pk2(v.x, v.y); o.y = pk2(v.z, v.w); o0[64 * j] = o; o1[64 * j] = o; }
        if (F.lane == 0) { tok_s0[m] = s0; tok_s1[m] = s1; }
    }
}
struct FinRow { v2u x0[4], x1[4]; f32x4 h[4]; float g0, g1; };
__device__ __forceinline__ void fin_load(FinRow& r, const Args& A, const LAS int* offs, int m, int lane) {
    const bf16* SO = (const bf16*)(A.ws + WS_SOUT);
    const int* tok_e = (const int*)(A.ws + WS_TOK); const float* tok_g0 = (const float*)(tok_e + 3 * M); const float* tok_g1 = (const float*)(tok_e + 4 * M);
    const int* tok_r0 = tok_e + M; const int* tok_r1 = tok_e + 2 * M;
    const int ee = tok_e[m], s0 = offs[ee & 255] + tok_r0[m], s1 = offs[(ee >> 8) & 255] + tok_r1[m]; r.g0 = tok_g0[m]; r.g1 = tok_g1[m];
    const f32x4* hr = (const f32x4*)(A.out + (size_t)m * D) + lane;
    const v2u* a0 = (const v2u*)(SO + (size_t)s0 * D) + lane; const v2u* a1 = (const v2u*)(SO + (size_t)s1 * D) + lane;
#pragma unroll
    for (int j = 0; j < 4; ++j) { r.x0[j] = a0[64 * j]; r.x1[j] = a1[64 * j]; r.h[j] = hr[64 * j]; }
}
__device__ __forceinline__ void fin_store(const FinRow& r, const Args& A, float* outp, int m, int lane) {
    const f32x4* gf4 = (const f32x4*)A.in[I_GFIN] + lane; f32x4* orow = (f32x4*)(outp + (size_t)m * D) + lane;
    f32x4 v[4]; float s = 0.f; const float g0 = r.g0, g1 = r.g1;
#pragma unroll
    for (int j = 0; j < 4; ++j) { const v2u x0 = r.x0[j], x1 = r.x1[j]; f32x4 h = r.h[j];
        h.x += g0 * bflo(x0.x) + g1 * bflo(x1.x); h.y += g0 * bfhi(x0.x) + g1 * bfhi(x1.x); h.z += g0 * bflo(x0.y) + g1 * bflo(x1.y); h.w += g0 * bfhi(x0.y) + g1 * bfhi(x1.y);
        v[j] = h; s += (h.x * h.x + h.y * h.y) + (h.z * h.z + h.w * h.w); }
    const float rs = rsqrtf(wave_sum(s) * (1.f / D) + RMS_EPS);
#pragma unroll
    for (int j = 0; j < 4; ++j) orow[64 * j] = v[j] * rs * gf4[64 * j];
}
__device__ __forceinline__ void p7_final(const Frame& F, const Args& A, float* outp) {
    const int gw = blockIdx.x * NWAVES + F.wave, NGW = F.G * NWAVES;
    const LAS int* offs = (const LAS int*)(F.lds + OFFS_OFF);
    FinRow ra, rb;
    int m = gw;
    if (m < M) fin_load(ra, A, offs, m, F.lane);
#pragma unroll 1
    for (; m < M; m += 2 * NGW) {
        const int m1 = m + NGW, m2 = m + 2 * NGW;
        if (m1 < M) fin_load(rb, A, offs, m1, F.lane);
        fin_store(ra, A, outp, m, F.lane);
        if (m2 < M) fin_load(ra, A, offs, m2, F.lane);
        if (m1 < M) fin_store(rb, A, outp, m1, F.lane);
    }
}

__global__ void __launch_bounds__(NTHREADS, 2) fwd_kernel(Args args) {
    extern __shared__ __attribute__((aligned(16))) unsigned char lds_raw[];
    Frame F;
    F.lds = (LAS unsigned char*)lds_raw;
    F.tid = threadIdx.x; F.lane = F.tid & 63; F.wave = __builtin_amdgcn_readfirstlane(F.tid >> 6); F.G = gridDim.x;
    F.ctl = (unsigned*)(args.ws + WS_CTL);
#define PHASE_ARGS Frame Fp = F; { int l_ = (int)__builtin_amdgcn_mbcnt_hi(~0u, __builtin_amdgcn_mbcnt_lo(~0u, 0u)); asm volatile("" : "+v"(l_)); Fp.lane = l_; Fp.tid = Fp.wave * 64 + l_; }
#define T0_() (F.wave == 0 && __builtin_amdgcn_mbcnt_hi(~0u, __builtin_amdgcn_mbcnt_lo(~0u, 0u)) == 0u)
    const Args& A = args;
    volatile LAS unsigned* MISC = (volatile LAS unsigned*)(F.lds + MISC_OFF);
    for (int u = F.tid; u < (LDS_BYTES - RING_BYTES) / 4; u += NTHREADS) ((LAS unsigned*)(F.lds + RING_BYTES))[u] = 0u;
    __syncthreads();
    const int lo = args.ph_lo, hi = args.ph_hi;
    XcdBarrier bar; bar.bar = F.ctl + CW_BAR; bar.x = 0; bar.st = nullptr;
    if (hi - lo > 1) bar = xcd_barrier_post(F.ctl + CW_BAR, MISC + 8, T0_());
#define IN(k) (lo <= (k) && (k) < hi)
#ifndef PH_MASK
#define PH_MASK 0x7ff
#endif
#define PH_EN(k) (((PH_MASK) >> (k)) & 1)
#ifndef PH_DUP
#define PH_DUP 0
#endif
#define REP(k) for (int rep_ = 0; rep_ < 1 + (((PH_DUP) >> (k)) & 1); ++rep_)
#define SEAM(k) do { if (IN(k) && IN((k) + 1)) xcd_barrier(bar, T0_()); } while (0)
    PB(20); if (PH_EN(0) && IN(0)) REP(0) { PHASE_ARGS p0_prologue(Fp, A); } PE(20); PB(40); SEAM(0); PE(40);
    PB(21); if (PH_EN(1) && IN(1)) REP(1) { PHASE_ARGS
        pg8::Gemm g{(const pg8::bf16_t*)(A.ws + WS_XN), (const pg8::bf16_t*)(A.ws + WS_WIN), M, DIN, D}; pg8::StaticOrder S; S.init(M, DIN, Fp.G, (int)blockIdx.x);
        pg8::EpiZ E{(pg8::bf16_t*)(A.ws + WS_ZC), (pg8::bf16_t*)(A.ws + WS_ZR)};
        pg8::gemm_phase<pg8::EpiZ, pg8::StaticOrder, true, true>(Fp.lds, g, S, E, Fp.tid);
    } PE(21); PB(41); SEAM(1); PE(41);
    PB(22); if (PH_EN(2) && IN(2)) REP(2) { PHASE_ARGS p2a_mix(Fp, A); } PE(22); PB(42); SEAM(2); PE(42);
    PB(23); if (PH_EN(3) && IN(3)) REP(3) { PHASE_ARGS pa_phase(Fp, A); } PE(23); PB(43); SEAM(3); PE(43);
    PB(24); if (PH_EN(4) && IN(4)) REP(4) { PHASE_ARGS
        if ((int)blockIdx.x < BATCH * HEADS) { PB(60); ps_scan(Fp, A, (int)blockIdx.x); PE(60); }
        else { PB(61); expert_convert(Fp, A, ((int)blockIdx.x - BATCH * HEADS) * NWAVES + Fp.wave, (Fp.G - BATCH * HEADS) * NWAVES); PE(61); }
    } PE(24); PB(44); SEAM(4); PE(44);
    PB(25); if (PH_EN(5) && IN(5)) REP(5) { PHASE_ARGS pc_phase(Fp, A); } PE(25); PB(45); SEAM(5); PE(45);
    PB(26); if (PH_EN(6) && IN(6)) REP(6) { PHASE_ARGS
        pg8::Gemm g{(const pg8::bf16_t*)(A.ws + WS_Y), (const pg8::bf16_t*)(A.ws + WS_WOUT), M, D, D}; pg8::StaticOrder S; S.init(M, D, Fp.G, (int)blockIdx.x);
        pg8::EpiResF32 E{A.in[I_X], A.out, D};
        pg8::gemm_phase<pg8::EpiResF32, pg8::StaticOrder, true, true>(Fp.lds, g, S, E, Fp.tid);
    } PE(26); PB(46); SEAM(6); PE(46);
    PB(27); if (PH_EN(7) && IN(7)) REP(7) { PHASE_ARGS p5_router(Fp, A, rep_ == (((PH_DUP) >> 7) & 1)); } PE(27); PB(47); SEAM(7); PE(47);
    PB(28); if (PH_EN(8) && IN(8)) REP(8) { PHASE_ARGS
        load_offsets(Fp, A);
        pg8::Gemm g{(const pg8::bf16_t*)(A.ws + WS_HN), (const pg8::bf16_t*)(A.ws + WS_WGU), MAXSLOTS, 512, D};
        pg8::MoeGatherOrder S; S.init((const LAS int*)(Fp.lds + OFFS_OFF), 2, Fp.G, (int)blockIdx.x, (size_t)512 * D * 2); S.gmap = (const int*)(A.ws + WS_TOKMAP);
        pg8::EpiSwiGLU E{(pg8::bf16_t*)(A.ws + WS_HID), DE};
        pg8::gemm_phase<pg8::EpiSwiGLU, pg8::MoeGatherOrder, true, true, true>(Fp.lds, g, S, E, Fp.tid);
    } PE(28); PB(48); SEAM(8); PE(48);
    PB(29); if (PH_EN(9) && IN(9)) REP(9) { PHASE_ARGS
        load_offsets(Fp, A);
        int kv = DE; asm volatile("" : "+s"(kv));
        pg8::Gemm g{(const pg8::bf16_t*)(A.ws + WS_HID), (const pg8::bf16_t*)(A.ws + WS_WD), MAXSLOTS, D, kv};
        pg8::MoeOrder S; S.init((const LAS int*)(Fp.lds + OFFS_OFF), 4, Fp.G, (int)blockIdx.x, (size_t)D * DE * 2);
        pg8::EpiPlainBf16 E{(pg8::bf16_t*)(A.ws + WS_SOUT), D};
        pg8::gemm_phase<pg8::EpiPlainBf16, pg8::MoeOrder, true, true>(Fp.lds, g, S, E, Fp.tid);
    } PE(29); PB(49); SEAM(9); PE(49);
    PB(30); if (PH_EN(10) && IN(10)) REP(10) { PHASE_ARGS load_offsets(Fp, A); p7_final(Fp, A, (rep_ == (((PH_DUP) >> 10) & 1)) ? A.out : (float*)(A.ws + WS_HN)); } PE(30);
    if (PROBE_ID >= 0 && PT0_) { const unsigned long long acc_ = *(volatile LAS unsigned long long*)(F.lds + MISC_OFF + 64); const unsigned long long t1_ = __builtin_amdgcn_s_memrealtime() + 8ull * acc_;
        while (__builtin_amdgcn_s_memrealtime() < t1_) __builtin_amdgcn_s_sleep(8); }
#undef IN
#undef SEAM
}

extern "C" void kernel_launch(void* const* d_in, const int* in_sizes, int n_in, void* d_out, int out_size, void* d_ws, size_t ws_size, hipStream_t stream) {
    static int grid = 0;
    if (grid == 0) {
        if (n_in != 25 || in_sizes[0] != M * D || out_size != M * D || ws_size < WS_END) { fprintf(stderr, "kernel_launch: unexpected shapes (n_in %d, in0 %d, out %d, ws %zu)\n", n_in, n_in > 0 ? in_sizes[0] : -1, out_size, ws_size); grid = -1; return; }
        int dev = 0, cus = 0, per_cu = 0;
        if (hipGetDevice(&dev) != hipSuccess || hipDeviceGetAttribute(&cus, hipDeviceAttributeMultiprocessorCount, dev) != hipSuccess) { grid = -1; return; }
        if (hipFuncSetAttribute((const void*)fwd_kernel, hipFuncAttributeMaxDynamicSharedMemorySize, LDS_BYTES) != hipSuccess) { fprintf(stderr, "kernel_launch: hipFuncSetAttribute failed\n"); grid = -1; return; }
        if (hipOccupancyMaxActiveBlocksPerMultiprocessor(&per_cu, (const void*)fwd_kernel, NTHREADS, LDS_BYTES) != hipSuccess || per_cu < 1) { fprintf(stderr, "kernel_launch: occupancy query says %d blocks per CU\n", per_cu); per_cu = 1; }
        (void)hipGetLastError();
        grid = cus;
    }
    if (grid < 0) return;
    (void)hipMemsetAsync((char*)d_ws + WS_CTL, 0, CTL_ZERO_BYTES, stream);
    Args a{};
    for (int i = 0; i < 25; ++i) a.in[i] = (const float*)d_in[i];
    a.out = (float*)d_out; a.ws = (unsigned char*)d_ws;
#if MK_N_LAUNCHES == 1
    a.ph_lo = 0; a.ph_hi = NPHASES;
    void* kargs[] = {&a};
    hipError_t e = hipLaunchCooperativeKernel((const void*)fwd_kernel, dim3(grid), dim3(NTHREADS), kargs, LDS_BYTES, stream);
    if (e != hipSuccess) fprintf(stderr, "kernel_launch: cooperative launch failed: %s (grid %d)\n", hipGetErrorString(e), grid);
#else
    for (int p = 0; p < NPHASES; ++p) { a.ph_lo = p; a.ph_hi = p + 1; hipLaunchKernelGGL(fwd_kernel, dim3(grid), dim3(NTHREADS), LDS_BYTES, stream, a); }
#endif
}
```
